# Optimizing an MI355X kernel written in HIP

```python
import math
import jax
import jax.numpy as jnp
from jax import lax
import numpy as np

D_MODEL = 1024
BATCH = 4
SEQ = 8192
DEPTH = 4

BLOCK = 128
HEAD_DIM = 64
N_BRANCH = 4
BRANCH_WIDTH = 512
EPS = 1e-6

A_HEADS = 8
IDX_HEADS = 8
IDX_DIM = 32
TOPK_MAX = 256

B_GROUPS = ((128, 1), (512, 4), (2048, 16))
B_HEADS = 8

C_HEADS = 8
C_NOPE = 64
C_ROPE = 32
C_V = 64
C_Q_LORA = 256
C_KV_LORA = 128
ROPE_THETA = 10000.0

D_HEADS = 8
D_KV_HEADS = 2
D_WINDOW = 128

NUM_BUCKETS = 32
MAX_DISTANCE = 2048
N_BIAS_HEADS = A_HEADS + len(B_GROUPS) * B_HEADS + D_HEADS

A_SIZES = (A_HEADS * HEAD_DIM, A_HEADS * HEAD_DIM, A_HEADS * HEAD_DIM, BRANCH_WIDTH,
           IDX_HEADS * IDX_DIM, IDX_DIM, IDX_HEADS)
B_SIZES = (len(B_GROUPS) * B_HEADS * HEAD_DIM,) * 3 + (BRANCH_WIDTH,)
C_SIZES = (C_Q_LORA, C_KV_LORA, C_ROPE, BRANCH_WIDTH)
D_SIZES = (D_HEADS * HEAD_DIM, D_KV_HEADS * HEAD_DIM, D_KV_HEADS * HEAD_DIM, BRANCH_WIDTH)
GATE_SIZES = (D_MODEL,) * N_BRANCH
IN_GROUPS = (A_SIZES, B_SIZES, C_SIZES, D_SIZES, GATE_SIZES)
N_IN = sum(sum(s) for s in IN_GROUPS)

kernel_name = 'hybrid_parallel_gated_mixers'


def rms_norm(x, gain):
    xf = x.astype(jnp.float32)
    y = xf * lax.rsqrt(jnp.mean(xf * xf, axis=-1, keepdims=True) + EPS)
    return (y * gain.astype(jnp.float32)).astype(x.dtype)


def t5_bucket(dist):
    max_exact = NUM_BUCKETS // 2
    d = jnp.maximum(dist, 0)
    logd = jnp.log(jnp.maximum(d, 1).astype(jnp.float32) / max_exact)
    large = max_exact + (logd / math.log(MAX_DISTANCE / max_exact) * (NUM_BUCKETS - max_exact)).astype(jnp.int32)
    return jnp.where(d < max_exact, d, jnp.minimum(large, NUM_BUCKETS - 1))


def rope(x, pos):
    half = x.shape[-1] // 2
    freq = ROPE_THETA ** (-jnp.arange(half, dtype=jnp.float32) / half)
    ang = pos.astype(jnp.float32)[:, None] * freq[None, :]
    cos, sin = jnp.cos(ang)[:, None, :], jnp.sin(ang)[:, None, :]
    xf = x.astype(jnp.float32)
    x1, x2 = xf[..., :half], xf[..., half:]
    return jnp.concatenate([x1 * cos - x2 * sin, x2 * cos + x1 * sin], axis=-1).astype(x.dtype)


def combined_projection(xn, w):
    groups = []
    start = 0
    for sizes in IN_GROUPS:
        width = sum(sizes)
        h = xn @ w[:, start:start + width]
        cuts, acc = [], 0
        for s in sizes[:-1]:
            acc += s
            cuts.append(acc)
        groups.append(jnp.split(h, cuts, axis=-1))
        start += width
    return groups


def blockify(t, nb):
    return t.reshape(t.shape[0], nb, BLOCK, *t.shape[2:]).swapaxes(0, 1)


def band_bias(table, step):
    rel = BLOCK + jnp.arange(BLOCK)[:, None] - jnp.arange(2 * BLOCK)[None, :]
    return table[t5_bucket(rel * step)].transpose(2, 0, 1)


def banded_attention(q, k, v, max_dist, bias, sink=None):
    b, L, hq, dh = q.shape
    hkv = k.shape[2]
    g = hq // hkv
    nb = L // BLOCK
    qb = q.reshape(b, nb, BLOCK, hkv, g, dh)

    def with_prev(t):
        tb = t.reshape(b, nb, BLOCK, hkv, dh)
        prev = jnp.pad(tb[:, :-1], ((0, 0), (1, 0), (0, 0), (0, 0), (0, 0)))
        return jnp.concatenate([prev, tb], axis=2)

    kb, vb = with_prev(k), with_prev(v)
    s = jnp.einsum('bnqkgd,bnskd->bnkgqs', qb, kb, preferred_element_type=jnp.float32) * dh ** -0.5
    s = s + bias.reshape(hkv, g, BLOCK, 2 * BLOCK).astype(jnp.float32)
    kj = jnp.arange(2 * BLOCK)[None, :]
    rel = BLOCK + jnp.arange(BLOCK)[:, None] - kj
    key_ok = (jnp.arange(nb)[:, None, None] * BLOCK - BLOCK + kj[None]) >= 0
    mask = (rel >= 0)[None] & (rel <= max_dist)[None] & key_ok
    s = jnp.where(mask[None, :, None, None], s, -jnp.inf)
    m = jnp.max(s, axis=-1)
    if sink is not None:
        sk = sink.astype(jnp.float32).reshape(hkv, g)[None, None, :, :, None]
        m = jnp.maximum(m, sk)
    p = jnp.exp(s - m[..., None])
    den = jnp.sum(p, axis=-1)
    if sink is not None:
        den = den + jnp.exp(sk - m)
    den_q = jnp.moveaxis(den, -1, 2)
    o = jnp.einsum('bnkgqs,bnskd->bnqkgd', p, vb.astype(jnp.float32)) / den_q[..., None]
    return (o.reshape(b, L, hq, dh), jnp.moveaxis(m, -1, 2).reshape(b, L, hq), den_q.reshape(b, L, hq))


def dsa_attention(q, k, v, iq, ik, iw, bias_table):
    b, S, h, dh = q.shape
    nb = S // BLOCK
    k_sel = min(TOPK_MAX, S // 4)
    key_pos = jnp.arange(S)

    def one_block(args):
        qb, iqb, iwb, qpos = args
        rel = jax.nn.relu(jnp.einsum('bqhd,bsd->bqhs', iqb, ik, preferred_element_type=jnp.float32))
        score = jnp.einsum('bqhs,bqh->bqs', rel, iwb.astype(jnp.float32))
        score = jnp.where(key_pos[None, None, :] <= qpos[None, :, None], score, -jnp.inf)
        _, idx = lax.top_k(score, k_sel)
        valid = idx <= qpos[None, :, None]
        ks = jax.vmap(lambda kk, ii: kk[ii])(k, idx)
        vs = jax.vmap(lambda vv, ii: vv[ii])(v, idx)
        logits = jnp.einsum('bqhd,bqkhd->bhqk', qb, ks, preferred_element_type=jnp.float32) * dh ** -0.5
        bias = bias_table[t5_bucket(qpos[None, :, None] - idx)]
        logits = logits + bias.transpose(0, 3, 1, 2).astype(jnp.float32)
        logits = jnp.where(valid[:, None], logits, -jnp.inf)
        p = jax.nn.softmax(logits, axis=-1)
        return jnp.einsum('bhqk,bqkhd->bqhd', p, vs.astype(jnp.float32))

    out = lax.map(one_block, (blockify(q, nb), blockify(iq, nb), blockify(iw, nb), key_pos.reshape(nb, BLOCK)))
    return out.swapaxes(0, 1).reshape(b, S, h, dh)


def dilated_mixture(q, k, v, rel_bias):
    b, S, _, h, dh = q.shape
    outs, ms, dens = [], [], []
    for g, (window, dil) in enumerate(B_GROUPS):
        sub_len = S // dil
        pad_len = -(-sub_len // BLOCK) * BLOCK

        def to_sub(t):
            t = t.reshape(b, sub_len, dil, h, dh).transpose(0, 2, 1, 3, 4).reshape(b * dil, sub_len, h, dh)
            return jnp.pad(t, ((0, 0), (0, pad_len - sub_len), (0, 0), (0, 0)))

        def from_sub(t):
            t = t[:, :sub_len]
            return t.reshape(b, dil, sub_len, *t.shape[2:]).swapaxes(1, 2).reshape(b, S, *t.shape[2:])

        table = rel_bias[:, A_HEADS + g * B_HEADS:A_HEADS + (g + 1) * B_HEADS]
        o, m, den = banded_attention(to_sub(q[:, :, g]), to_sub(k[:, :, g]), to_sub(v[:, :, g]),
                                     window // dil, band_bias(table, dil))
        outs.append(from_sub(o))
        ms.append(from_sub(m))
        dens.append(from_sub(den))
    m_all = jnp.stack(ms)
    w = jnp.stack(dens) * jnp.exp(m_all - jnp.max(m_all, axis=0, keepdims=True))
    w = w / jnp.sum(w, axis=0, keepdims=True)
    return sum(w[g][..., None] * outs[g] for g in range(len(B_GROUPS)))


def causal_dense_attention(q, k, v):
    b, S, h, dqk = q.shape
    nb = S // BLOCK
    key_pos = jnp.arange(S)
    vf = v.astype(jnp.float32)

    def one_block(args):
        qb, qpos = args
        s = jnp.einsum('bqhd,bshd->bhqs', qb, k, preferred_element_type=jnp.float32) * dqk ** -0.5
        s = jnp.where(key_pos[None, :] <= qpos[:, None], s, -jnp.inf)
        p = jax.nn.softmax(s, axis=-1)
        return jnp.einsum('bhqs,bshd->bqhd', p, vf)

    out = lax.map(one_block, (blockify(q, nb), key_pos.reshape(nb, BLOCK)))
    return out.swapaxes(0, 1).reshape(b, S, h, v.shape[-1])


def setup_inputs(seed: int = 0) -> dict:
    key = jax.random.key(seed)
    ks = jax.random.split(key, 16)
    f32 = jnp.float32

    def normal(k, shape, scale):
        return jax.random.normal(k, shape, f32) * scale

    def gain(k, shape):
        return 1.0 + 0.05 * jax.random.normal(k, shape, f32)

    return {
        'x': normal(ks[0], (BATCH, SEQ, D_MODEL), 1.0),
        'norm_gain': gain(ks[1], (DEPTH, D_MODEL)),
        'w_in': normal(ks[2], (DEPTH, D_MODEL, N_IN), D_MODEL ** -0.5),
        'qk_gain_a': gain(ks[3], (DEPTH, 2, HEAD_DIM)),
        'qk_gain_b': gain(ks[4], (DEPTH, 2, HEAD_DIM)),
        'qk_gain_c': gain(ks[5], (DEPTH, 2, C_NOPE + C_ROPE)),
        'qk_gain_d': gain(ks[6], (DEPTH, 2, HEAD_DIM)),
        'c_q_gain': gain(ks[7], (DEPTH, C_Q_LORA)),
        'c_kv_gain': gain(ks[8], (DEPTH, C_KV_LORA)),
        'w_q_b': normal(ks[9], (DEPTH, C_Q_LORA, C_HEADS * (C_NOPE + C_ROPE)), C_Q_LORA ** -0.5),
        'w_kv_b': normal(ks[10], (DEPTH, C_KV_LORA, C_HEADS * (C_NOPE + C_V)), C_KV_LORA ** -0.5),
        'sinks': normal(ks[11], (DEPTH, D_HEADS), 0.5),
        'rel_bias': normal(ks[12], (NUM_BUCKETS, N_BIAS_HEADS), 0.1),
        'w_branch': normal(ks[13], (DEPTH, N_BRANCH, BRANCH_WIDTH, D_MODEL), BRANCH_WIDTH ** -0.5),
        'w_out': normal(ks[14], (DEPTH, D_MODEL, D_MODEL), D_MODEL ** -0.5),
    }


def reference(x, norm_gain, w_in, qk_gain_a, qk_gain_b, qk_gain_c, qk_gain_d, c_q_gain, c_kv_gain,
              w_q_b, w_kv_b, sinks, rel_bias, w_branch, w_out):
    b, S, _ = x.shape
    pos = jnp.arange(S)
    bias_a = rel_bias[:, :A_HEADS]
    bias_d = rel_bias[:, N_BIAS_HEADS - D_HEADS:]
    n_g = len(B_GROUPS)
    for l in range(DEPTH):
        xn = rms_norm(x, norm_gain[l])
        ((a_q, a_k, a_v, a_z, a_iq, a_ik, a_iw), (b_q, b_k, b_v, b_z),
         (c_q, c_kv, c_pe, c_z), (d_q, d_k, d_v, d_z), gates) = combined_projection(xn, w_in[l])

        shp_a = (b, S, A_HEADS, HEAD_DIM)
        qa = rms_norm(a_q.reshape(shp_a), qk_gain_a[l, 0])
        ka = rms_norm(a_k.reshape(shp_a), qk_gain_a[l, 1])
        ya = dsa_attention(qa, ka, a_v.reshape(shp_a), a_iq.reshape(b, S, IDX_HEADS, IDX_DIM), a_ik, a_iw, bias_a)

        shp_b = (b, S, n_g, B_HEADS, HEAD_DIM)
        qbm = rms_norm(b_q.reshape(shp_b), qk_gain_b[l, 0])
        kbm = rms_norm(b_k.reshape(shp_b), qk_gain_b[l, 1])
        yb = dilated_mixture(qbm, kbm, b_v.reshape(shp_b), rel_bias)

        qc = (rms_norm(c_q, c_q_gain[l]) @ w_q_b[l]).reshape(b, S, C_HEADS, C_NOPE + C_ROPE)
        kv = (rms_norm(c_kv, c_kv_gain[l]) @ w_kv_b[l]).reshape(b, S, C_HEADS, C_NOPE + C_V)
        kc = jnp.concatenate([kv[..., :C_NOPE],
                              jnp.broadcast_to(c_pe[:, :, None, :], (b, S, C_HEADS, C_ROPE))], axis=-1)
        qc = rms_norm(qc, qk_gain_c[l, 0])
        kc = rms_norm(kc, qk_gain_c[l, 1])
        qc = jnp.concatenate([qc[..., :C_NOPE], rope(qc[..., C_NOPE:], pos)], axis=-1)
        kc = jnp.concatenate([kc[..., :C_NOPE], rope(kc[..., C_NOPE:], pos)], axis=-1)
        yc = causal_dense_attention(qc, kc, kv[..., C_NOPE:])

        qd = rms_norm(d_q.reshape(b, S, D_HEADS, HEAD_DIM), qk_gain_d[l, 0])
        kd = rms_norm(d_k.reshape(b, S, D_KV_HEADS, HEAD_DIM), qk_gain_d[l, 1])
        yd, _, _ = banded_attention(qd, kd, d_v.reshape(b, S, D_KV_HEADS, HEAD_DIM),
                                    D_WINDOW - 1, band_bias(bias_d, 1), sinks[l])

        ys = (ya, yb, yc, yd)
        zs = (a_z, b_z, c_z, d_z)
        merged = sum(jax.nn.sigmoid(gates[n]) *
                     ((ys[n].reshape(b, S, BRANCH_WIDTH).astype(x.dtype) * jax.nn.silu(zs[n])) @ w_branch[l, n])
                     for n in range(N_BRANCH))
        x = x + merged @ w_out[l]
    return x
```

```cpp
#include <hip/hip_runtime.h>
#include <hip/hip_cooperative_groups.h>
#include <cstdio>
#include <cstdint>
#include <cmath>
namespace cg = cooperative_groups;

#define LAS __attribute__((address_space(3)))
typedef unsigned short bf16_t;
typedef short bf16x8 __attribute__((ext_vector_type(8)));
typedef float f32x4 __attribute__((ext_vector_type(4)));
typedef unsigned u32x4 __attribute__((ext_vector_type(4)));
typedef unsigned u32x2 __attribute__((ext_vector_type(2)));

constexpr int DM = 1024, NBATCH = 4, SEQ = 8192, DEPTH = 4, TT = NBATCH * SEQ;
constexpr int NIN = 13768, NP1 = 9728, NHC = 9672;
constexpr int AQ = 0, AK = 512, AV = 1024, AZ = 1536, AIQ = 2048, AIK = 2304, AIW = 2336;
constexpr int BQ = 2368, BKK = 3904, BV = 5440, BZ = 6976;
constexpr int CKV = 7488, CPE = 7616, CQ = 7680, CZ = 7936;
constexpr int DQ = 8448, DK = 8960, DV = 9088, DZ = 9216;
constexpr int NBH = 40;
constexpr float LOG2E = 1.4426950408889634f;
constexpr int NTHREADS = 512;
constexpr int LDS_BYTES = 147456;
constexpr int LDS_MISC = 131072 + 256;

struct Params {
    const float* x; const float* norm_gain; const float* w_in; const float* qga; const float* qgb; const float* qgc; const float* qgd;
    const float* cq_gain; const float* ckv_gain; const float* w_q_b; const float* w_kv_b; const float* sinks; const float* rel_bias;
    const float* w_branch; const float* w_out;
    float* out; unsigned char* ws;
    int nbc; int pad;
};

struct WsMap { size_t biasd, bnd, ctl, winT, wgT, wbrT, woT, wqbT, wkvbT, lut, rope, xb, h, qc, kc, kv, mask, md, yz, mg, mgb, total; };
__host__ __device__ inline WsMap make_map(int nbc) {
    WsMap m; size_t o = 0; const size_t Tc = (size_t)nbc * SEQ;
    m.ctl = o; o += 32768;
    m.winT = o; o += (size_t)DEPTH * NP1 * DM * 2;
    m.wgT = o; o += (size_t)DEPTH * 4096 * DM * 2;
    m.wbrT = o; o += (size_t)DEPTH * 4 * 1024 * 512 * 2;
    m.woT = o; o += (size_t)DEPTH * 1024 * 1024 * 2;
    m.wqbT = o; o += (size_t)DEPTH * 768 * 256 * 2;
    m.wkvbT = o; o += (size_t)DEPTH * 1024 * 128 * 2;
    m.lut = o; o += 8192;
    m.biasd = o; o += (size_t)NBH * SEQ * 4;
    m.bnd = o; o += 256;
    m.rope = o; o += (size_t)SEQ * 32 * 4;
    m.xb = o; o += (size_t)TT * DM * 2;
    m.h = o; o += Tc * NP1 * 2;
    m.qc = o; o += Tc * 768 * 2;
    m.kc = o; o += Tc * 768 * 2;
    m.kv = o; o += Tc * 1024 * 2;
    m.mask = o; o += Tc * 1024;
    m.md = o; o += Tc * 48 * 4;
    m.yz = o; o += Tc * 2048 * 2;
    m.mg = o; o += Tc * 1024 * 4;
    m.mgb = o; o += Tc * 1024 * 2;
    m.total = o; return m;
}

__device__ __forceinline__ int otid() { int t = __builtin_amdgcn_workitem_id_x(); asm volatile("" : "+v"(t)); return t; }
__device__ __forceinline__ int obid() { int t = __builtin_amdgcn_workgroup_id_x(); asm volatile("" : "+s"(t)); return t; }
__device__ __forceinline__ float bf2f(unsigned h) { return __uint_as_float(h << 16); }
__device__ __forceinline__ unsigned f2bf(float f) { unsigned u = __float_as_uint(f); return (u + 0x7fffu + ((u >> 16) & 1u)) >> 16; }
__device__ __forceinline__ unsigned pk2(float lo, float hi) { unsigned r; asm volatile("v_cvt_pk_bf16_f32 %0, %1, %2" : "=v"(r) : "v"(lo), "v"(hi)); return r; }
__device__ __forceinline__ void unpack8(const u32x4 w, float (&f)[8]) {
    f[0] = __uint_as_float(w.x << 16); f[1] = __uint_as_float(w.x & 0xffff0000u);
    f[2] = __uint_as_float(w.y << 16); f[3] = __uint_as_float(w.y & 0xffff0000u);
    f[4] = __uint_as_float(w.z << 16); f[5] = __uint_as_float(w.z & 0xffff0000u);
    f[6] = __uint_as_float(w.w << 16); f[7] = __uint_as_float(w.w & 0xffff0000u);
}
__device__ __forceinline__ u32x4 pack8(const float (&f)[8]) { u32x4 w; w.x = pk2(f[0], f[1]); w.y = pk2(f[2], f[3]); w.z = pk2(f[4], f[5]); w.w = pk2(f[6], f[7]); return w; }
__device__ __forceinline__ float fexp2(float x) { return __builtin_amdgcn_exp2f(x); }
__device__ __forceinline__ float silu_f(float z) { return z * __builtin_amdgcn_rcpf(1.0f + fexp2(-LOG2E * z)); }
__device__ __forceinline__ float sigmoid_f(float z) { return __builtin_amdgcn_rcpf(1.0f + fexp2(-LOG2E * z)); }
__device__ __forceinline__ int t5_bucket_dev(int d) {
    if (d < 16) return d < 0 ? 0 : d;
    const float logd = logf((float)d / 16.0f);
    int large = 16 + (int)(logd / 4.852030263919617f * 16.0f);
    return large < 31 ? large : 31;
}

namespace pg8 {
constexpr int BM = 256, BK = 64, HALF = 128, HTB = HALF * BK * 2, NXCD = 8, WGM = 8;
__host__ __device__ __forceinline__ int lds_byte(int r, int c) { const int st = (r >> 4) * 2 + (c >> 5), rr = r & 15, cc = c & 31, ob = rr * 64 + cc * 2; return st * 1024 + (ob ^ (((ob >> 9) & 1) << 5)); }
__host__ __device__ __forceinline__ void stage_rc(int b, int& R, int& C) { const int st = b / 1024, sb = b % 1024, swz = sb ^ (((sb >> 9) & 1) << 5); R = (st >> 1) * 16 + swz / 64; C = (st & 1) * 32 + (swz % 64) / 2; }
__host__ __device__ __forceinline__ int perm32(int rho) { const int n = rho >> 4, i = rho & 15; return 8 * (i >> 2) + 4 * n + (i & 3); }
struct Unit { int pm, pn, pb; };
struct Gemm { const bf16_t* A; const bf16_t* Bt; int M, N, K, lda; size_t bstepA, bstepB; };
struct StaticOrder {
    int nM, nN, nwg, G, c;
    __host__ __device__ __forceinline__ void init(int M, int N, int G_, int c_) { nM = M / BM; nN = N / BM; nwg = nM * nN; G = G_; c = c_; }
    __host__ __device__ bool next(int i, Unit& u) const {
        const long L = (long)i * G + c; if (L >= nwg) return false;
        int wgid = (int)L; { const int q = nwg / NXCD, r = nwg % NXCD, xcd = wgid % NXCD, off = wgid / NXCD; wgid = (xcd < r ? xcd * (q + 1) : r * (q + 1) + (xcd - r) * q) + off; }
        const int nig = WGM * nN, gid = wgid / nig, fm = gid * WGM, gsz = (nM - fm) < WGM ? (nM - fm) : WGM;
        u.pm = fm + ((wgid % nig) % gsz); u.pn = (wgid % nig) / gsz; u.pb = 0; return true;
    }
    __device__ __forceinline__ void a_ready(const Unit&) const {}
    __device__ __forceinline__ void done(const Unit&) const {}
};
struct BatchOrder4 {
    StaticOrder base;
    __device__ __forceinline__ bool next(int i, Unit& u) const { if (!base.next(i >> 2, u)) return false; u.pb = i & 3; return true; }
    __device__ __forceinline__ void a_ready(const Unit&) const {}
    __device__ __forceinline__ void done(const Unit&) const {}
};
template <class Epi, class Sched>
__device__ __forceinline__ void gemm_phase(LAS unsigned char* lds, const Gemm g, const Sched& S, const Epi& E) {
    const int tid = otid(), wid = __builtin_amdgcn_readfirstlane(tid >> 6), lane = tid & 63, wr = wid >> 2, wc = wid & 3, fr = lane & 15, fq = lane >> 4;
    const int K = g.K, nt = K / BK, lda = g.lda;
    unsigned voffA[2], voffB[2];
#pragma unroll
    for (int i = 0; i < 2; ++i) { int R, C; stage_rc(tid * 16 + i * 8192, R, C); const int Rb = (R & ~31) + perm32(R & 31);
        voffA[i] = (unsigned)(R * lda + C) * 2u; voffB[i] = (unsigned)(Rb * K + C) * 2u; }
    const size_t kstep = (size_t)(BK * 2);
    const size_t hstepA = (size_t)HALF * lda * 2, hstepB = (size_t)HALF * K * 2;
    const size_t tstepA = 2 * hstepA, tstepB = 2 * hstepB;
    const unsigned ldsw = (unsigned)wid * 1024u;
    const int aoff = lds_byte(wr * 64 + fr, fq * 8), boff = lds_byte(wc * 32 + fr, fq * 8);
#define PG8_SA(b, h) (((b) * 2 + (h)) * HTB)
#define PG8_SB(b, h) ((4 + (b) * 2 + (h)) * HTB)
#define PG8_STAGE(bufoff, gbase, voff) do { _Pragma("unroll") for (int _i = 0; _i < 2; ++_i) \
        __builtin_amdgcn_global_load_lds((const unsigned*)((const char*)(gbase) + (voff)[_i]), (LAS unsigned*)(lds + (bufoff) + ldsw + _i * 8192), 16, 0, 0); } while (0)
#define PG8_LDA(dst, b, h) do { _Pragma("unroll") for (int m = 0; m < 4; ++m) _Pragma("unroll") for (int k = 0; k < 2; ++k) dst[m][k] = *(const LAS bf16x8*)(lds + PG8_SA(b, h) + aoff + m * 2048 + k * 1024); } while (0)
#define PG8_LDB(dst, b, h) do { _Pragma("unroll") for (int n = 0; n < 2; ++n) _Pragma("unroll") for (int k = 0; k < 2; ++k) dst[n][k] = *(const LAS bf16x8*)(lds + PG8_SB(b, h) + boff + n * 2048 + k * 1024); } while (0)
#define PG8_MMA(ai, bj, At, Bt) do { __builtin_amdgcn_s_setprio(1); _Pragma("unroll") for (int m = 0; m < 4; ++m) _Pragma("unroll") for (int n = 0; n < 2; ++n) _Pragma("unroll") for (int k = 0; k < 2; ++k) \
        acc[ai][bj][m][n] = __builtin_amdgcn_mfma_f32_16x16x32_bf16(Bt[n][k], At[m][k], acc[ai][bj][m][n], 0, 0, 0); __builtin_amdgcn_s_setprio(0); } while (0)
#define PG8_WAIT_V(n) asm volatile("s_waitcnt vmcnt(" #n ")" ::: "memory")
#define PG8_WAIT_L(n) asm volatile("s_waitcnt lgkmcnt(" #n ")" ::: "memory")
#define PG8_BAR __builtin_amdgcn_s_barrier()
#define PG8_SCHED __builtin_amdgcn_sched_barrier(0)
    Unit cur, nxt; int ui = 0;
    if (!S.next(0, cur)) return;
    f32x4 acc[2][2][4][2];
#pragma unroll
    for (int a = 0; a < 2; ++a)
#pragma unroll
        for (int b = 0; b < 2; ++b)
#pragma unroll
            for (int m = 0; m < 4; ++m)
#pragma unroll
                for (int n = 0; n < 2; ++n) acc[a][b][m][n] = (f32x4){0.f, 0.f, 0.f, 0.f};
    bf16x8 At[4][2], B0[2][2], B1[2][2];
    const char* cA = (const char*)g.A + (size_t)cur.pm * tstepA + (size_t)cur.pb * g.bstepA; const char* cB = (const char*)g.Bt + (size_t)cur.pn * tstepB + (size_t)cur.pb * g.bstepB;
    S.a_ready(cur);
    PG8_STAGE(PG8_SB(0, 0), cB, voffB); PG8_STAGE(PG8_SB(0, 1), cB + hstepB, voffB); PG8_STAGE(PG8_SA(0, 0), cA, voffA); PG8_STAGE(PG8_SA(0, 1), cA + hstepA, voffA);
    if (wr == 1) PG8_BAR;
    PG8_WAIT_V(2); PG8_BAR;
    PG8_STAGE(PG8_SB(1, 0), cB + kstep, voffB); PG8_STAGE(PG8_SA(1, 0), cA + kstep, voffA); PG8_STAGE(PG8_SB(1, 1), cB + hstepB + kstep, voffB);
    PG8_WAIT_V(6); PG8_BAR;
    for (;;) {
        const bool has_next = S.next(ui + 1, nxt);
        const char* nA = has_next ? (const char*)g.A + (size_t)nxt.pm * tstepA + (size_t)nxt.pb * g.bstepA : cA; const char* nB = has_next ? (const char*)g.Bt + (size_t)nxt.pn * tstepB + (size_t)nxt.pb * g.bstepB : cB;
        for (int t = 0; t < nt; t += 2) {
            const bool last = (t == nt - 2);
            const char* a1 = cA + (size_t)(t + 1) * kstep;
            const char* a2 = last ? nA : cA + (size_t)(t + 2) * kstep; const char* b2 = last ? nB : cB + (size_t)(t + 2) * kstep;
            const char* a3 = a2 + kstep; const char* b3 = b2 + kstep;
            if (last && has_next) S.a_ready(nxt);
            PG8_LDB(B0, 0, 0); PG8_LDB(B1, 0, 1); PG8_SCHED; PG8_LDA(At, 0, 0); PG8_STAGE(PG8_SA(1, 1), a1 + hstepA, voffA);
            PG8_WAIT_V(8); PG8_WAIT_L(0); PG8_BAR; PG8_MMA(0, 0, At, B0); PG8_MMA(0, 1, At, B1); PG8_BAR; PG8_SCHED;
            PG8_LDA(At, 0, 1); PG8_STAGE(PG8_SB(0, 0), b2, voffB); PG8_STAGE(PG8_SB(0, 1), b2 + hstepB, voffB); PG8_STAGE(PG8_SA(0, 0), a2, voffA);
            PG8_WAIT_V(8); PG8_WAIT_L(0); PG8_BAR; PG8_MMA(1, 0, At, B0); PG8_MMA(1, 1, At, B1); PG8_BAR; PG8_SCHED;
            PG8_LDB(B0, 1, 0); PG8_LDB(B1, 1, 1); PG8_SCHED; PG8_LDA(At, 1, 0); PG8_STAGE(PG8_SA(0, 1), a2 + hstepA, voffA);
            PG8_WAIT_V(8); PG8_WAIT_L(0); PG8_BAR; PG8_MMA(0, 0, At, B0); PG8_MMA(0, 1, At, B1); PG8_BAR; PG8_SCHED;
            PG8_LDA(At, 1, 1); PG8_STAGE(PG8_SB(1, 0), b3, voffB); PG8_STAGE(PG8_SB(1, 1), b3 + hstepB, voffB); PG8_STAGE(PG8_SA(1, 0), a3, voffA);
            PG8_WAIT_V(8); PG8_WAIT_L(0); PG8_BAR; PG8_MMA(1, 0, At, B0); PG8_MMA(1, 1, At, B1); PG8_BAR; PG8_SCHED;
        }
        if (wr == 0) PG8_BAR;
        E(acc, cur, wr, wc, fr, fq); S.done(cur);
        if (!has_next) break;
#pragma unroll
        for (int a = 0; a < 2; ++a)
#pragma unroll
            for (int b = 0; b < 2; ++b)
#pragma unroll
                for (int m = 0; m < 4; ++m)
#pragma unroll
                    for (int n = 0; n < 2; ++n) acc[a][b][m][n] = (f32x4){0.f, 0.f, 0.f, 0.f};
        cur = nxt; cA = nA; cB = nB; ++ui;
        if (wr == 1) PG8_BAR;
    }
    PG8_WAIT_V(0);
    PG8_BAR;
#undef PG8_SA
#undef PG8_SB
#undef PG8_STAGE
#undef PG8_LDA
#undef PG8_LDB
#undef PG8_MMA
#undef PG8_WAIT_V
#undef PG8_WAIT_L
#undef PG8_BAR
#undef PG8_SCHED
}

struct EpiStore {
    bf16_t* O; int ldc; int act;
    __device__ __forceinline__ void operator()(const f32x4 (&acc)[2][2][4][2], const Unit& u, int wr, int wc, int fr, int fq) const {
        const int row0 = u.pm * BM + wr * 64 + fr; const int col0 = u.pn * BM + wc * 32 + 8 * fq;
#pragma unroll
        for (int ai = 0; ai < 2; ++ai)
#pragma unroll
            for (int m = 0; m < 4; ++m) { bf16_t* rowp = O + (size_t)(row0 + ai * HALF + m * 16) * ldc + col0;
#pragma unroll
                for (int bj = 0; bj < 2; ++bj) { f32x4 v0 = acc[ai][bj][m][0], v1 = acc[ai][bj][m][1];
                    if (act == 1) {
#pragma unroll
                        for (int e = 0; e < 4; ++e) { v0[e] = sigmoid_f(v0[e]); v1[e] = sigmoid_f(v1[e]); }
                    }
                    u32x4 w; w.x = pk2(v0[0], v0[1]); w.y = pk2(v0[2], v0[3]); w.z = pk2(v1[0], v1[1]); w.w = pk2(v1[2], v1[3]);
                    *(u32x4*)(rowp + bj * HALF) = w; } }
    }
};
struct EpiStoreNorm {
    bf16_t* O; const float* qga; const float* qgb; const float* qgd; LAS float* P; const float* cqg; const float* ckvg;
    __device__ __forceinline__ void operator()(const f32x4 (&acc)[2][2][4][2], const Unit& u, int wr, int wc, int fr, int fq) const {
        const int wid = wr * 4 + wc;
        const int row0 = u.pm * BM + wr * 64 + fr; const int col0 = u.pn * BM + wc * 32 + 8 * fq;
        const float qs = 0.125f * LOG2E;
        const float* gl[2]; float sc[2]; int typ[2];
#pragma unroll
        for (int bj = 0; bj < 2; ++bj) {
            const int c = u.pn * BM + bj * HALF + (wc >> 1) * 64;
            const float* gp = nullptr; sc[bj] = 1.0f; typ[bj] = 0;
            if (c < 512) { gp = qga; sc[bj] = qs; } else if (c < 1024) gp = qga + 64;
            else if (c >= BQ && c < BQ + 1536) { gp = qgb; sc[bj] = qs; } else if (c >= BKK && c < BKK + 1536) gp = qgb + 64;
            else if (c >= DQ && c < DQ + 512) { gp = qgd; sc[bj] = qs; } else if (c >= DK && c < DK + 128) gp = qgd + 64;
            if (gp) { typ[bj] = 1; gl[bj] = gp + (wc & 1) * 32 + fq * 8; }
            else if (c >= CKV && c < CKV + 128) { typ[bj] = 2; gl[bj] = ckvg + (c - CKV) + (wc & 1) * 32 + fq * 8; }
            else if (c >= CQ && c < CQ + 256) { typ[bj] = 3; gl[bj] = cqg + (c - CQ) + (wc & 1) * 32 + fq * 8; }
            else gl[bj] = qga;
        }
        unsigned pown = (unsigned)((wid * 256 + fr) * 4), ppar = (unsigned)(((wid ^ 1) * 256 + fr) * 4), phal = (unsigned)((wr * 4 * 256 + fr) * 4);
        asm volatile("" : "+v"(pown), "+v"(ppar), "+v"(phal));
        LAS unsigned char* Pb = (LAS unsigned char*)P;
#pragma unroll
        for (int ai = 0; ai < 2; ++ai)
#pragma unroll
            for (int m = 0; m < 4; ++m)
#pragma unroll
                for (int bj = 0; bj < 2; ++bj) {
                    const f32x4 v0 = acc[ai][bj][m][0], v1 = acc[ai][bj][m][1];
                    float t = v0[0] * v0[0] + v0[1] * v0[1] + v0[2] * v0[2] + v0[3] * v0[3] + v1[0] * v1[0] + v1[1] * v1[1] + v1[2] * v1[2] + v1[3] * v1[3];
                    t += __shfl_xor(t, 16); t += __shfl_xor(t, 32);
                    if (fq == 0) *(LAS float*)(Pb + pown + ((ai * 4 + m) * 2 + bj) * 64) = t;
                }
        asm volatile("s_waitcnt lgkmcnt(0)" ::: "memory"); __builtin_amdgcn_s_barrier(); asm volatile("" ::: "memory");
#pragma unroll
        for (int bj = 0; bj < 2; ++bj) {
            f32x4 g0 = (f32x4){1.f, 1.f, 1.f, 1.f}, g1 = g0;
            if (typ[bj]) { g0 = *(const f32x4*)gl[bj] * sc[bj]; g1 = *(const f32x4*)(gl[bj] + 4) * sc[bj]; }
            const float invn = typ[bj] == 3 ? (1.0f / 256.0f) : (typ[bj] == 2 ? (1.0f / 128.0f) : (1.0f / 64.0f));
#pragma unroll
            for (int ai = 0; ai < 2; ++ai)
#pragma unroll
                for (int m = 0; m < 4; ++m) {
                    f32x4 v0 = acc[ai][bj][m][0], v1 = acc[ai][bj][m][1];
                    if (typ[bj]) {
                        const int ko = ((ai * 4 + m) * 2) * 64;
                        float tot;
                        if (typ[bj] == 1) tot = *(const LAS float*)(Pb + pown + ko + bj * 64) + *(const LAS float*)(Pb + ppar + ko + bj * 64);
                        else if (typ[bj] == 2)
                            tot = (*(const LAS float*)(Pb + phal + 2 * 1024 + ko) + *(const LAS float*)(Pb + phal + 3 * 1024 + ko)) + (*(const LAS float*)(Pb + phal + ko + 64) + *(const LAS float*)(Pb + phal + 1024 + ko + 64));
                        else {
                            tot = 0.f;
#pragma unroll
                            for (int w = 0; w < 4; ++w) tot += *(const LAS float*)(Pb + phal + w * 1024 + ko) + *(const LAS float*)(Pb + phal + w * 1024 + ko + 64);
                        }
                        const float rs = rsqrtf(tot * invn + 1e-6f);
#pragma unroll
                        for (int e = 0; e < 4; ++e) { v0[e] = v0[e] * rs * g0[e]; v1[e] = v1[e] * rs * g1[e]; }
                    }
                    u32x4 w; w.x = pk2(v0[0], v0[1]); w.y = pk2(v0[2], v0[3]); w.z = pk2(v1[0], v1[1]); w.w = pk2(v1[2], v1[3]);
                    *(u32x4*)(O + (size_t)(row0 + ai * HALF + m * 16) * NP1 + col0 + bj * HALF) = w;
                    __builtin_amdgcn_sched_barrier(0);
                }
        }
    }
};
struct EpiBranch {
    bf16_t* MGb; const bf16_t* G; int ldg;
    __device__ __forceinline__ void operator()(const f32x4 (&acc)[2][2][4][2], const Unit& u, int wr, int wc, int fr, int fq) const {
        const int row0 = u.pm * BM + wr * 64 + fr; const int col0 = u.pn * BM + wc * 32 + 8 * fq;
        const bf16_t* Gb = G + u.pb * 1024; const bool first = (u.pb == 0);
#pragma unroll
        for (int ai = 0; ai < 2; ++ai)
#pragma unroll
            for (int m = 0; m < 4; ++m) { const size_t row = (size_t)(row0 + ai * HALF + m * 16);
#pragma unroll
                for (int bj = 0; bj < 2; ++bj) { const int col = col0 + bj * HALF;
                    const u32x4 gw = *(const u32x4*)(Gb + row * ldg + col);
                    const u32x4 ow = first ? (u32x4){0u, 0u, 0u, 0u} : *(const u32x4*)(MGb + row * 1024 + col);
                    float gf[8], of[8]; unpack8(gw, gf); unpack8(ow, of);
                    const f32x4 v0 = acc[ai][bj][m][0], v1 = acc[ai][bj][m][1];
#pragma unroll
                    for (int e = 0; e < 4; ++e) { of[e] += v0[e] * gf[e]; of[4 + e] += v1[e] * gf[4 + e]; }
                    *(u32x4*)(MGb + row * 1024 + col) = pack8(of); } }
    }
};
struct EpiOut {
    const float* xin; float* out;
    __device__ __forceinline__ void operator()(const f32x4 (&acc)[2][2][4][2], const Unit& u, int wr, int wc, int fr, int fq) const {
        const int row0 = u.pm * BM + wr * 64 + fr; const int col0 = u.pn * BM + wc * 32 + 8 * fq;
#pragma unroll
        for (int ai = 0; ai < 2; ++ai)
#pragma unroll
            for (int m = 0; m < 4; ++m) { const size_t row = (size_t)(row0 + ai * HALF + m * 16);
#pragma unroll
                for (int bj = 0; bj < 2; ++bj) { const size_t off = row * 1024 + col0 + bj * HALF;
                    const f32x4 x0 = *(const f32x4*)(xin + off), x1 = *(const f32x4*)(xin + off + 4);
                    *(f32x4*)(out + off) = x0 + acc[ai][bj][m][0]; *(f32x4*)(out + off + 4) = x1 + acc[ai][bj][m][1]; } }
    }
};
}


#define XB_TMO      128
#define XB_XCNT(j)  (256  + 64 * (j))
#define XB_XSUB(j)  (1280 + 64 * (j))
#define XB_XGEN(j)  (2304 + 64 * (j))
#define XB_TOP      3328
#define XB_TOPGEN   3392
#define XCD_BAR_WORDS 3456
#define XB_SPIN_CAP (1u << 22)
__device__ __forceinline__ unsigned xb_ld(unsigned* p)              { return __hip_atomic_load(p, __ATOMIC_RELAXED, __HIP_MEMORY_SCOPE_AGENT); }
__device__ __forceinline__ unsigned xb_add(unsigned* p, unsigned v) { return __hip_atomic_fetch_add(p, v, __ATOMIC_RELAXED, __HIP_MEMORY_SCOPE_AGENT); }
__device__ __forceinline__ unsigned xb_xcc_id() { return (unsigned)__builtin_amdgcn_s_getreg((3 << 11) | 20) & 0xFu; }
#define XB_SPIN(cond, bar) do { unsigned _sp = 0; while (cond) { __builtin_amdgcn_s_sleep(1); \
    if ((++_sp & 255u) == 0u) { if (xb_ld(&(bar)[XB_TMO])) break; if (_sp > XB_SPIN_CAP) { atomicAdd(&(bar)[XB_TMO], 1u); break; } } } } while (0)
struct XcdBarrier { unsigned* bar; unsigned x; volatile LAS unsigned* st; };
__device__ __forceinline__ XcdBarrier xcd_barrier_post(unsigned* bar, volatile LAS unsigned* st) {
    XcdBarrier b; b.bar = bar; b.x = xb_xcc_id(); b.st = st;
    if (threadIdx.x == 0) (void)xb_add(&bar[XB_XCNT(b.x)], 1u);
    return b;
}
__device__ __forceinline__ void xcd_barrier_complete(unsigned* bar, unsigned x, unsigned& nloc, unsigned& nx) {
    const unsigned G = gridDim.x * gridDim.y * gridDim.z;
    unsigned sum, cnt, mine, sp = 0u;
    for (;;) {
        sum = 0u; cnt = 0u; mine = 0u;
#pragma unroll
        for (unsigned j = 0; j < 16; ++j) { const unsigned c = xb_ld(&bar[XB_XCNT(j)]); sum += c; cnt += (c > 0u) ? 1u : 0u; mine = (j == x) ? c : mine; }
        if (sum == G) break;
        __builtin_amdgcn_s_sleep(1);
        if ((++sp & 255u) == 0u) { if (xb_ld(&bar[XB_TMO])) break; if (sp > XB_SPIN_CAP) { atomicAdd(&bar[XB_TMO], 1u); break; } }
    }
    nloc = mine > 0u ? mine : 1u; nx = cnt > 0u ? cnt : 1u;
}
__device__ __forceinline__ void xcd_barrier(const XcdBarrier& b) {
    asm volatile("s_waitcnt vmcnt(0)" ::: "memory");
    __syncthreads();
    if (threadIdx.x == 0) {
        unsigned* bar = b.bar;
        __builtin_amdgcn_s_waitcnt(0);
        unsigned nloc = b.st[0], nx = b.st[1];
        if (nloc == 0u) { xcd_barrier_complete(bar, b.x, nloc, nx); b.st[0] = nloc; b.st[1] = nx; }
        const unsigned old = xb_add(&bar[XB_XSUB(b.x)], 1u);
        const unsigned gen = old / nloc;
        if (old + 1u == (gen + 1u) * nloc) {
            __builtin_amdgcn_fence(__ATOMIC_RELEASE, "agent");
            asm volatile("s_waitcnt vmcnt(0)" ::: "memory");
            const unsigned og = xb_add(&bar[XB_TOP], 1u);
            const unsigned tg = og / nx;
            if (og + 1u == (tg + 1u) * nx) xb_add(&bar[XB_TOPGEN], 1u);
            else XB_SPIN(xb_ld(&bar[XB_TOPGEN]) == tg, bar);
            __builtin_amdgcn_fence(__ATOMIC_ACQUIRE, "agent");
            xb_add(&bar[XB_XGEN(b.x)], 1u);
            asm volatile("s_waitcnt vmcnt(0)" ::: "memory");
        } else {
            XB_SPIN(xb_ld(&bar[XB_XGEN(b.x)]) == gen, bar);
            __builtin_amdgcn_fence(__ATOMIC_ACQUIRE, "agent");
            asm volatile("s_waitcnt vmcnt(0)" ::: "memory");
        }
    }
    __syncthreads();
}

__device__ __forceinline__ int next_unit(int* counter, LAS unsigned char* lds) {
    LAS int* slot = (LAS int*)(lds + LDS_MISC);
    __syncthreads();
    if (otid() == 0) *slot = atomicAdd(counter, 1);
    __syncthreads();
    return __builtin_amdgcn_readfirstlane(*slot);
}

__device__ __forceinline__ void tr_tile(LAS unsigned char* lds, const float* src, int pitch, int K, int c0, int nc, bf16_t* dst, int tile) {
    LAS float* T = (LAS float*)lds;
    const int nkt = K / 64; const int kt = tile % nkt, ntl = tile / nkt; const int k0 = kt * 64, n0 = ntl * 64;
    const int tid = otid();
    __syncthreads();
    {
        const int r = (tid >> 4), c4 = (tid & 15) * 4;
        f32x4 v0 = (f32x4){0.f, 0.f, 0.f, 0.f}, v1 = v0;
        if (n0 + c4 + 4 <= nc) { v0 = *(const f32x4*)(src + (size_t)(k0 + r) * pitch + c0 + n0 + c4); v1 = *(const f32x4*)(src + (size_t)(k0 + r + 32) * pitch + c0 + n0 + c4); }
        T[r * 65 + c4 + 0] = v0[0]; T[r * 65 + c4 + 1] = v0[1]; T[r * 65 + c4 + 2] = v0[2]; T[r * 65 + c4 + 3] = v0[3];
        T[(r + 32) * 65 + c4 + 0] = v1[0]; T[(r + 32) * 65 + c4 + 1] = v1[1]; T[(r + 32) * 65 + c4 + 2] = v1[2]; T[(r + 32) * 65 + c4 + 3] = v1[3];
    }
    __syncthreads();
    const int n = tid >> 3, kc = (tid & 7) * 8;
    if (n0 + n < nc) {
        float f[8];
#pragma unroll
        for (int i = 0; i < 8; ++i) f[i] = T[(kc + i) * 65 + n];
        *(u32x4*)(dst + (size_t)(n0 + n) * K + k0 + kc) = pack8(f);
    }
}

__device__ __forceinline__ void setup_phase(const Params& p, const WsMap& wm, LAS unsigned char* lds) {
    constexpr int T_WIN = 16 * 152, T_WG = 16 * 64, T_WBR = 4 * 8 * 16, T_WO = 16 * 16, T_WQB = 4 * 12, T_WKVB = 2 * 16;
    constexpr int T_LAYER = T_WIN + T_WG + T_WBR + T_WO + T_WQB + T_WKVB;
    for (int t = obid(); t < DEPTH * T_LAYER; t += gridDim.x) {
        const int l = t / T_LAYER; int r = t % T_LAYER;
        if (r < T_WIN) {
            const float* src = p.w_in + (size_t)l * DM * NIN; bf16_t* dst = (bf16_t*)(p.ws + wm.winT) + (size_t)l * NP1 * DM;
            int c0, nc, d0, t = r;
            if (t < 16 * 37) { c0 = 0; nc = 2344; d0 = 0; }
            else if ((t -= 16 * 37) < 16 * 80) { c0 = 2344; nc = 5120; d0 = BQ; }
            else if ((t -= 16 * 80) < 16 * 4) { c0 = 7464; nc = 256; d0 = CQ; }
            else if ((t -= 16 * 4) < 16 * 2) { c0 = 7720; nc = 128; d0 = CKV; }
            else if ((t -= 16 * 2) < 16 * 1) { c0 = 7848; nc = 32; d0 = CPE; }
            else if ((t -= 16 * 1) < 16 * 8) { c0 = 7880; nc = 512; d0 = CZ; }
            else { t -= 16 * 8; c0 = 8392; nc = 1280; d0 = DQ; }
            tr_tile(lds, src, NIN, DM, c0, nc, dst + (size_t)d0 * DM, t); continue;
        }
        r -= T_WIN;
        if (r < T_WG) { tr_tile(lds, p.w_in + (size_t)l * DM * NIN, NIN, DM, NHC, 4096, (bf16_t*)(p.ws + wm.wgT) + (size_t)l * 4096 * DM, r); continue; }
        r -= T_WG;
        if (r < T_WBR) { const int b = r / (8 * 16); tr_tile(lds, p.w_branch + ((size_t)l * 4 + b) * 512 * 1024, 1024, 512, 0, 1024, (bf16_t*)(p.ws + wm.wbrT) + ((size_t)l * 4 + b) * 1024 * 512, r % (8 * 16)); continue; }
        r -= T_WBR;
        if (r < T_WO) { tr_tile(lds, p.w_out + (size_t)l * 1024 * 1024, 1024, 1024, 0, 1024, (bf16_t*)(p.ws + wm.woT) + (size_t)l * 1024 * 1024, r); continue; }
        r -= T_WO;
        if (r < T_WQB) { tr_tile(lds, p.w_q_b + (size_t)l * 256 * 768, 768, 256, 0, 768, (bf16_t*)(p.ws + wm.wqbT) + (size_t)l * 768 * 256, r); continue; }
        r -= T_WQB;
        tr_tile(lds, p.w_kv_b + (size_t)l * 128 * 1024, 1024, 128, 0, 1024, (bf16_t*)(p.ws + wm.wkvbT) + (size_t)l * 1024 * 128, r);
    }
    const int gtid = obid() * NTHREADS + otid(), gsz = gridDim.x * NTHREADS;
    unsigned char* lut = p.ws + wm.lut;
    for (int d = gtid; d < SEQ; d += gsz) lut[d] = (unsigned char)t5_bucket_dev(d);
    {
        float* biasd = (float*)(p.ws + wm.biasd);
        for (int e = gtid; e < NBH * SEQ; e += gsz) { const int col = e / SEQ, d = e % SEQ; biasd[e] = p.rel_bias[t5_bucket_dev(d) * NBH + col] * LOG2E; }
        if (obid() == 0 && otid() < 64) {
            const int lane = otid();
            float bm = 0.f;
            for (int i = lane; i < 32 * NBH; i += 64) bm = fmaxf(bm, fabsf(p.rel_bias[i]));
#pragma unroll
            for (int o = 1; o < 64; o <<= 1) bm = fmaxf(bm, __shfl_xor(bm, o));
            float* bnd = (float*)(p.ws + wm.bnd);
            for (int l = 0; l < DEPTH; ++l)
                for (int br = 0; br < 4; ++br) {
                    const float* g = (br == 0) ? p.qga : (br == 1) ? p.qgb : (br == 2) ? p.qgc : p.qgd; const int dim = (br == 2) ? 96 : 64;
                    float a = 0.f, b = 0.f;
                    for (int i = lane; i < dim; i += 64) { a = fmaxf(a, fabsf(g[(l * 2) * dim + i])); b = fmaxf(b, fabsf(g[(l * 2 + 1) * dim + i])); }
#pragma unroll
                    for (int o = 1; o < 64; o <<= 1) { a = fmaxf(a, __shfl_xor(a, o)); b = fmaxf(b, __shfl_xor(b, o)); }
                    if (lane == 0) bnd[l * 4 + br] = sqrtf((float)dim) * a * b * LOG2E * 1.03f + ((br == 2) ? 0.f : bm * LOG2E) + 0.25f;
                }
        }
    }
    float* rope = (float*)(p.ws + wm.rope);
    for (int e = gtid; e < SEQ * 16; e += gsz) {
        const int pos = e >> 4, i = e & 15;
        const float freq = (float)pow(10000.0, -(double)i / 16.0);
        const float ang = (float)pos * freq;
        rope[pos * 32 + i] = (float)cos((double)ang); rope[pos * 32 + 16 + i] = (float)sin((double)ang);
    }
}

__device__ __forceinline__ void p0_phase(const float* xin, const float* gain, bf16_t* xb) {
    const int lane = otid() & 63; const int gw = (obid() * NTHREADS + otid()) >> 6, nw = (gridDim.x * NTHREADS) >> 6;
    f32x4 g[4];
#pragma unroll
    for (int i = 0; i < 4; ++i) g[i] = *(const f32x4*)(gain + i * 256 + lane * 4);
    for (int row = gw; row < TT; row += nw) {
        const float* xr = xin + (size_t)row * DM; f32x4 v[4]; float ss = 0.f;
#pragma unroll
        for (int i = 0; i < 4; ++i) { v[i] = *(const f32x4*)(xr + i * 256 + lane * 4); ss += v[i][0] * v[i][0] + v[i][1] * v[i][1] + v[i][2] * v[i][2] + v[i][3] * v[i][3]; }
#pragma unroll
        for (int o = 1; o < 64; o <<= 1) ss += __shfl_xor(ss, o);
        const float rs = rsqrtf(ss * (1.0f / DM) + 1e-6f);
#pragma unroll
        for (int i = 0; i < 4; ++i) { u32x2 w; w.x = pk2(v[i][0] * rs * g[i][0], v[i][1] * rs * g[i][1]); w.y = pk2(v[i][2] * rs * g[i][2], v[i][3] * rs * g[i][3]);
            *(u32x2*)(xb + (size_t)row * DM + i * 256 + lane * 4) = w; }
    }
}

__device__ __forceinline__ void norm8(u32x4& w, const float (&g)[8], int nl, float inv_gs, bool act) {
    float f[8]; unpack8(w, f); float ss = 0.f;
#pragma unroll
    for (int i = 0; i < 8; ++i) ss += f[i] * f[i];
    if (!act) ss = 0.f;
    ss += __shfl_xor(ss, 1); ss += __shfl_xor(ss, 2); ss += __shfl_xor(ss, 4);
    if (nl > 8) ss += __shfl_xor(ss, 8);
    if (nl > 16) ss += __shfl_xor(ss, 16);
    const float rs = rsqrtf(ss * inv_gs + 1e-6f);
#pragma unroll
    for (int i = 0; i < 8; ++i) f[i] = f[i] * rs * g[i];
    w = pack8(f);
}
__device__ __forceinline__ void norm_phase(const Params& p, bf16_t* H, int Tc, int l) {
    const int lane = otid() & 63; const int gw = (obid() * NTHREADS + otid()) >> 6, nw = (gridDim.x * NTHREADS) >> 6;
    float gCq[8], gCkv[8];
#pragma unroll
    for (int i = 0; i < 8; ++i) { gCq[i] = p.cq_gain[l * 256 + (lane & 31) * 8 + i]; gCkv[i] = p.ckv_gain[l * 128 + (lane & 15) * 8 + i]; }
    const bool isq = lane < 32;
    const bool act = lane < 48;
    for (int row = gw; row < Tc; row += nw) {
        bf16_t* ptr = H + (size_t)row * NP1 + (isq ? CQ + lane * 8 : CKV + (lane - 32) * 8);
        u32x4 w = act ? *(const u32x4*)ptr : (u32x4){0u, 0u, 0u, 0u};
        float f[8]; unpack8(w, f); float ss = 0.f;
#pragma unroll
        for (int i = 0; i < 8; ++i) ss += f[i] * f[i];
        ss += __shfl_xor(ss, 1); ss += __shfl_xor(ss, 2); ss += __shfl_xor(ss, 4); ss += __shfl_xor(ss, 8);
        const float s16 = __shfl_xor(ss, 16);
        if (isq) ss += s16;
        const float rs = rsqrtf(ss * (isq ? (1.0f / 256.0f) : (1.0f / 128.0f)) + 1e-6f);
#pragma unroll
        for (int i = 0; i < 8; ++i) f[i] = f[i] * rs * (isq ? gCq[i] : gCkv[i]);
        if (act) *(u32x4*)ptr = pack8(f);
    }
}

__device__ __forceinline__ void mla_phase(const Params& p, const WsMap& wm, const bf16_t* H, bf16_t* QC, bf16_t* KC, const bf16_t* KV, int Tc, int l) {
    const int lane = otid() & 63; const int gw = (obid() * NTHREADS + otid()) >> 6, nw = (gridDim.x * NTHREADS) >> 6;
    const float* rope = (const float*)(p.ws + wm.rope);
    const int sub = lane & 15, hl = lane >> 4;
    const float qscale = 0.10206207261596577f * LOG2E;
    const bool act = sub < 12; const int gsub = act ? sub : 0;
    float gq[8], gk[8];
#pragma unroll
    for (int i = 0; i < 8; ++i) { gq[i] = p.qgc[(l * 2 + 0) * 96 + gsub * 8 + i] * qscale; gk[i] = p.qgc[(l * 2 + 1) * 96 + gsub * 8 + i]; }
    for (int row = gw; row < Tc; row += nw) {
        const int pos = row & (SEQ - 1);
        u32x4 w[4];
#pragma unroll
        for (int part = 0; part < 4; ++part) {
            const int isk = part >> 1, h = (part & 1) * 4 + hl;
            w[part] = (u32x4){0u, 0u, 0u, 0u};
            if (act) {
                if (!isk) w[part] = *(const u32x4*)(QC + (size_t)row * 768 + h * 96 + sub * 8);
                else if (sub < 8) w[part] = *(const u32x4*)(KV + (size_t)row * 1024 + h * 128 + sub * 8);
                else w[part] = *(const u32x4*)(H + (size_t)row * NP1 + CPE + (sub - 8) * 8);
            }
        }
        const float* cs = rope + pos * 32 + (sub & 1) * 8;
        const f32x4 c0 = *(const f32x4*)cs, c1 = *(const f32x4*)(cs + 4), s0 = *(const f32x4*)(cs + 16), s1 = *(const f32x4*)(cs + 20);
        const float cc[8] = {c0[0], c0[1], c0[2], c0[3], c1[0], c1[1], c1[2], c1[3]};
        const float sn[8] = {s0[0], s0[1], s0[2], s0[3], s1[0], s1[1], s1[2], s1[3]};
#pragma unroll
        for (int part = 0; part < 4; ++part) {
            const int isk = part >> 1, h = (part & 1) * 4 + hl;
            float f[8]; unpack8(w[part], f); float ss = 0.f;
#pragma unroll
            for (int i = 0; i < 8; ++i) ss += f[i] * f[i];
            ss += __shfl_xor(ss, 1); ss += __shfl_xor(ss, 2); ss += __shfl_xor(ss, 4); ss += __shfl_xor(ss, 8);
            const float rs = rsqrtf(ss * (1.0f / 96.0f) + 1e-6f);
#pragma unroll
            for (int i = 0; i < 8; ++i) f[i] = f[i] * rs * (isk ? gk[i] : gq[i]);
#pragma unroll
            for (int i = 0; i < 8; ++i) {
                const float other = __shfl_xor(f[i], 2);
                if (sub >= 8 && sub < 12) f[i] = (sub < 10) ? (f[i] * cc[i] - other * sn[i]) : (f[i] * cc[i] + other * sn[i]);
            }
            if (act) { bf16_t* dst = (isk ? KC : QC) + (size_t)row * 768 + h * 96 + sub * 8; *(u32x4*)dst = pack8(f); }
        }
    }
}

__device__ __forceinline__ void indexer_unit(LAS unsigned char* lds, const bf16_t* H, unsigned short* MASK16, int bl, int qb) {
    LAS unsigned* hist = (LAS unsigned*)lds;
    LAS unsigned* prefix = (LAS unsigned*)(lds + 32768);
    LAS unsigned* need = (LAS unsigned*)(lds + 32768 + 128);
    const int tid = otid(), wid = __builtin_amdgcn_readfirstlane(tid >> 6), lane = tid & 63, lr = lane & 15, lg = lane >> 4;
    const int q0 = qb * 32; const size_t rowbase = (size_t)bl * SEQ;
    const int nks = (q0 + 31) / 128 + 1;
    __syncthreads();
    if (tid < 32) { prefix[tid] = 0u; need[tid] = 256u; }
    bf16x8 iq[2][8]; float iw[2][8];
#pragma unroll
    for (int qt = 0; qt < 2; ++qt) {
        const bf16_t* hr = H + (rowbase + q0 + qt * 16 + lr) * NP1;
#pragma unroll
        for (int h = 0; h < 8; ++h) iq[qt][h] = *(const bf16x8*)(hr + AIQ + h * 32 + lg * 8);
        const u32x4 w = *(const u32x4*)(hr + AIW); float f[8]; unpack8(w, f);
#pragma unroll
        for (int h = 0; h < 8; ++h) iw[qt][h] = f[h];
    }
    const int tq0 = q0 + lr, tq1 = q0 + 16 + lr;
    for (int pass = 0; pass < 5; ++pass) {
        if (pass < 4) { for (int i = tid; i < 32 * 256; i += NTHREADS) hist[i] = 0u; }
        __syncthreads();
        const unsigned pf0 = prefix[lr], pf1 = prefix[16 + lr];
        const unsigned th0 = (tq0 < 256) ? 0u : pf0, th1 = (tq1 < 256) ? 0u : pf1;
        const int shp = (pass == 0) ? 0 : (32 - 8 * pass), shd = (pass < 4) ? (24 - 8 * pass) : 0;
        for (int ks = 0; ks < nks; ++ks) {
            const int kb = ks * 128 + wid * 16;
            const bf16x8 ikf = *(const bf16x8*)(H + (rowbase + kb + lr) * NP1 + AIK + lg * 8);
            float sc[2][4];
#pragma unroll
            for (int qt = 0; qt < 2; ++qt) {
#pragma unroll
                for (int j = 0; j < 4; ++j) sc[qt][j] = 0.f;
#pragma unroll
                for (int h = 0; h < 8; ++h) {
                    f32x4 a = (f32x4){0.f, 0.f, 0.f, 0.f};
                    a = __builtin_amdgcn_mfma_f32_16x16x32_bf16(ikf, iq[qt][h], a, 0, 0, 0);
#pragma unroll
                    for (int j = 0; j < 4; ++j) sc[qt][j] += iw[qt][h] * fmaxf(a[j], 0.f);
                }
            }
            if (pass < 4) {
#pragma unroll
                for (int qt = 0; qt < 2; ++qt) {
                    const int tq = qt ? tq1 : tq0; const unsigned pf = qt ? pf1 : pf0;
#pragma unroll
                    for (int j = 0; j < 4; ++j) {
                        const int key = kb + lg * 4 + j;
                        const unsigned u = __float_as_uint(sc[qt][j] + 0.0f);
                        const unsigned k32 = (u & 0x80000000u) ? ~u : (u | 0x80000000u);
                        const bool ok = (key <= tq) && (pass == 0 || (k32 >> shp) == pf);
                        if (ok) __hip_atomic_fetch_add(&hist[(qt * 16 + lr) * 256 + ((k32 >> shd) & 255u)], 1u, __ATOMIC_RELAXED, __HIP_MEMORY_SCOPE_WORKGROUP);
                    }
                }
            } else {
                unsigned bits[2];
#pragma unroll
                for (int qt = 0; qt < 2; ++qt) {
                    const int tq = qt ? tq1 : tq0; const unsigned th = qt ? th1 : th0;
                    unsigned b = 0u;
#pragma unroll
                    for (int j = 0; j < 4; ++j) {
                        const int key = kb + lg * 4 + j;
                        const unsigned u = __float_as_uint(sc[qt][j] + 0.0f);
                        const unsigned k32 = (u & 0x80000000u) ? ~u : (u | 0x80000000u);
                        if ((key <= tq) && (k32 >= th)) b |= 1u << (lg * 4 + j);
                    }
                    b |= __shfl_xor(b, 16); b |= __shfl_xor(b, 32);
                    bits[qt] = b;
                }
                if (lg == 0) {
                    MASK16[(rowbase + tq0) * 512 + ks * 8 + wid] = (unsigned short)bits[0];
                    MASK16[(rowbase + tq1) * 512 + ks * 8 + wid] = (unsigned short)bits[1];
                }
            }
        }
        if (pass < 4) {
            __syncthreads();
            for (int r = 0; r < 4; ++r) {
                const int row = wid * 4 + r;
                const unsigned c0 = hist[row * 256 + 255 - 4 * lane], c1 = hist[row * 256 + 254 - 4 * lane], c2 = hist[row * 256 + 253 - 4 * lane], c3 = hist[row * 256 + 252 - 4 * lane];
                const unsigned cs = c0 + c1 + c2 + c3; unsigned incl = cs;
#pragma unroll
                for (int o = 1; o < 64; o <<= 1) { const unsigned t = __shfl_up(incl, o); if (lane >= o) incl += t; }
                const unsigned excl = incl - cs; const unsigned nd = need[row];
                if (excl < nd && nd <= incl) {
                    unsigned a = excl; int dg; unsigned nn;
                    if (a + c0 >= nd) { dg = 255 - 4 * lane; nn = nd - a; }
                    else { a += c0; if (a + c1 >= nd) { dg = 254 - 4 * lane; nn = nd - a; }
                        else { a += c1; if (a + c2 >= nd) { dg = 253 - 4 * lane; nn = nd - a; } else { a += c2; dg = 252 - 4 * lane; nn = nd - a; } } }
                    prefix[row] = (prefix[row] << 8) | (unsigned)dg; need[row] = nn;
                }
            }
            __syncthreads();
        }
    }
    __syncthreads();
}

__device__ __forceinline__ void wave_find(unsigned c, unsigned need, int lane, int& sl, unsigned& excl_at) {
    unsigned incl = c;
#pragma unroll
    for (int o = 1; o < 64; o <<= 1) { const unsigned t = __shfl_up(incl, o); if (lane >= o) incl += t; }
    const unsigned excl = incl - c;
    const unsigned long long b = __builtin_amdgcn_ballot_w64(excl < need && need <= incl);
    sl = b ? (int)__builtin_ctzll(b) : 63;
    excl_at = __shfl(excl, sl);
}
__device__ __forceinline__ void idx_scores(const bf16x8 ikf, const bf16x8 (&iq)[2][8], const float (&iw)[2][8], const bf16x8 (&iql)[2][2], float (&sc)[2][4]) {
#pragma unroll
    for (int qt = 0; qt < 2; ++qt) {
        f32x4 L = (f32x4){0.f, 0.f, 0.f, 0.f};
        L = __builtin_amdgcn_mfma_f32_16x16x32_bf16(ikf, iql[qt][0], L, 0, 0, 0);
        L = __builtin_amdgcn_mfma_f32_16x16x32_bf16(ikf, iql[qt][1], L, 0, 0, 0);
#pragma unroll
        for (int j = 0; j < 4; ++j) sc[qt][j] = L[j];
#pragma unroll
        for (int h = 0; h < 8; ++h) {
            f32x4 a = (f32x4){0.f, 0.f, 0.f, 0.f};
            a = __builtin_amdgcn_mfma_f32_16x16x32_bf16(ikf, iq[qt][h], a, 0, 0, 0);
#pragma unroll
            for (int j = 0; j < 4; ++j) sc[qt][j] = __builtin_fmaf(iw[qt][h], __builtin_fabsf(a[j]), sc[qt][j]);
        }
    }
}
__device__ __forceinline__ unsigned mono_key(float s) { const unsigned u = __float_as_uint(s + 0.0f); return u ^ ((unsigned)((int)u >> 31) | 0x80000000u); }
__device__ __forceinline__ float key_edge(unsigned kk) { return __uint_as_float((kk & 0x80000000u) ? (kk ^ 0x80000000u) : ~kk); }
constexpr int ICAP = 512;
__device__ __forceinline__ bool indexer_fast(LAS unsigned char* lds, const bf16_t* H, unsigned char* MASKB, int bl, int qb) {
    LAS unsigned* H11 = (LAS unsigned*)lds;
    LAS unsigned* KL = (LAS unsigned*)lds;
    LAS unsigned short* IL = (LAS unsigned short*)(lds + 65536);
    LAS unsigned char* LM = lds + 98304;
    LAS int* tbin = (LAS int*)(lds + LDS_MISC + 128);
    LAS unsigned* need1 = (LAS unsigned*)(lds + LDS_MISC + 256);
    LAS unsigned* cc = (LAS unsigned*)(lds + LDS_MISC + 384);
    LAS unsigned* ovf = (LAS unsigned*)(lds + LDS_MISC + 512);
    LAS unsigned* hist2 = (LAS unsigned*)(lds + LDS_MISC + 1024);
    const int tid = otid(), wid = __builtin_amdgcn_readfirstlane(tid >> 6), lane = tid & 63, lr = lane & 15, lg = lane >> 4;
    const int q0 = qb * 32; const size_t rowbase = (size_t)bl * SEQ;
    const int nks = (q0 + 31) / 128 + 1;
    __syncthreads();
    for (int i = tid; i < 32 * 1025 / 4; i += NTHREADS) ((LAS u32x4*)H11)[i] = (u32x4){0u, 0u, 0u, 0u};
    if (tid < 32) cc[tid] = 0u;
    if (tid == 0) *ovf = 0u;
    bf16x8 iq[2][8]; float iw[2][8];
#pragma unroll
    for (int qt = 0; qt < 2; ++qt) {
        const bf16_t* hr = H + (rowbase + q0 + qt * 16 + lr) * NP1;
#pragma unroll
        for (int h = 0; h < 8; ++h) iq[qt][h] = *(const bf16x8*)(hr + AIQ + h * 32 + lg * 8);
        const u32x4 w = *(const u32x4*)(hr + AIW); float f[8]; unpack8(w, f);
#pragma unroll
        for (int h = 0; h < 8; ++h) iw[qt][h] = f[h];
    }
    bf16x8 iql[2][2];
#pragma unroll
    for (int qt = 0; qt < 2; ++qt) {
        float qa[8];
#pragma unroll
        for (int i = 0; i < 8; ++i) qa[i] = 0.f;
#pragma unroll
        for (int h = 0; h < 8; ++h) { float qf8[8]; unpack8(__builtin_bit_cast(u32x4, iq[qt][h]), qf8);
#pragma unroll
            for (int i = 0; i < 8; ++i) qa[i] += iw[qt][h] * qf8[i]; }
        float qh[8], ql[8];
#pragma unroll
        for (int i = 0; i < 8; ++i) { qh[i] = bf2f(f2bf(qa[i])); ql[i] = qa[i] - qh[i]; }
        iql[qt][0] = __builtin_bit_cast(bf16x8, pack8(qh)); iql[qt][1] = __builtin_bit_cast(bf16x8, pack8(ql));
    }
    const int tq0 = q0 + lr, tq1 = q0 + 16 + lr;
    __syncthreads();
    const bf16_t* ikp = H + (rowbase + wid * 16 + lr) * NP1 + AIK + lg * 8;
    bf16x8 ikn0 = *(const bf16x8*)ikp, ikn1 = *(const bf16x8*)(ikp + (size_t)(nks > 1 ? 1 : 0) * 128 * NP1);
    for (int ks = 0; ks < nks; ++ks) {
        const int kb = ks * 128 + wid * 16;
        const bf16x8 ikf = ikn0; ikn0 = ikn1;
        { const int kn = (ks + 2 < nks) ? ks + 2 : nks - 1; ikn1 = *(const bf16x8*)(ikp + (size_t)kn * 128 * NP1); }
        float sc[2][4]; idx_scores(ikf, iq, iw, iql, sc);
        const bool chk = (ks == nks - 1);
#pragma unroll
        for (int qt = 0; qt < 2; ++qt) {
            const int tq = qt ? tq1 : tq0;
#pragma unroll
            for (int j = 0; j < 4; ++j) {
                const int key = kb + lg * 4 + j;
                const unsigned bin = mono_key(sc[qt][j]) >> 21;
                unsigned inc = (bin & 1u) ? 65536u : 1u;
                if (chk) inc = (key <= tq) ? inc : 0u;
                __hip_atomic_fetch_add(&H11[(qt * 16 + lr) * 1025 + (bin >> 1)], inc, __ATOMIC_RELAXED, __HIP_MEMORY_SCOPE_WORKGROUP);
            }
        }
    }
#ifdef DUP_IDX_P0
    { ikn0 = *(const bf16x8*)ikp; ikn1 = ikn0;
      for (int ks = 0; ks < nks; ++ks) {
        const bf16x8 ikf = ikn0; ikn0 = ikn1;
        { const int kn = (ks + 2 < nks) ? ks + 2 : nks - 1; ikn1 = *(const bf16x8*)(ikp + (size_t)kn * 128 * NP1); }
        float sc[2][4]; idx_scores(ikf, iq, iw, iql, sc);
#pragma unroll
        for (int qt = 0; qt < 2; ++qt)
#pragma unroll
            for (int j = 0; j < 4; ++j) { const unsigned bin = mono_key(sc[qt][j]) >> 21; unsigned inc = (bin == 5000u) ? 1u : 0u;
                __hip_atomic_fetch_add(&H11[(qt * 16 + lr) * 1025 + (bin >> 1)], inc, __ATOMIC_RELAXED, __HIP_MEMORY_SCOPE_WORKGROUP); }
      } }
#endif
#ifdef DUP_IDX_SC
    { float dsum = 0.f;
      ikn0 = *(const bf16x8*)ikp; ikn1 = ikn0;
      for (int ks = 0; ks < nks; ++ks) {
        const bf16x8 ikf = ikn0; ikn0 = ikn1;
        { const int kn = (ks + 2 < nks) ? ks + 2 : nks - 1; ikn1 = *(const bf16x8*)(ikp + (size_t)kn * 128 * NP1); }
        float sc[2][4]; idx_scores(ikf, iq, iw, iql, sc);
#pragma unroll
        for (int qt = 0; qt < 2; ++qt)
#pragma unroll
            for (int j = 0; j < 4; ++j) dsum += sc[qt][j];
      }
      if (dsum == 12345.678f) MASKB[0] = 1; }
#endif
    __syncthreads();
    for (int r = 0; r < 4; ++r) {
        const int row = wid * 4 + r;
        if (q0 + row < 256) { if (lane == 0) { tbin[row] = -1; need1[row] = 0u; } continue; }
        const LAS unsigned* hp = H11 + row * 1025 + 1008 - 16 * lane;
        unsigned c = 0u;
#pragma unroll
        for (int i = 0; i < 16; ++i) { const unsigned w = hp[i]; c += (w & 0xffffu) + (w >> 16); }
        int L1; unsigned ex1; wave_find(c, 256u, lane, L1, ex1);
        const int top = 2047 - 32 * L1; const unsigned need2 = 256u - ex1;
        unsigned c2 = 0u;
        if (lane < 32) { const int bin = top - lane; const unsigned w = H11[row * 1025 + (bin >> 1)]; c2 = (bin & 1) ? (w >> 16) : (w & 0xffffu); }
        int L2; unsigned ex2; wave_find(c2, need2, lane, L2, ex2);
        if (lane == 0) { tbin[row] = top - L2; need1[row] = need2 - ex2; }
    }
    __syncthreads();
    {
        const int tb0 = tbin[lr], tb1 = tbin[16 + lr];
        const float lo0 = tb0 < 0 ? -INFINITY : key_edge((unsigned)tb0 << 21), hi0 = tb0 < 0 ? -INFINITY : (tb0 >= 2047 ? INFINITY : key_edge(((unsigned)tb0 + 1u) << 21));
        const float lo1 = tb1 < 0 ? -INFINITY : key_edge((unsigned)tb1 << 21), hi1 = tb1 < 0 ? -INFINITY : (tb1 >= 2047 ? INFINITY : key_edge(((unsigned)tb1 + 1u) << 21));
        ikn0 = *(const bf16x8*)ikp; ikn1 = *(const bf16x8*)(ikp + (size_t)(nks > 1 ? 1 : 0) * 128 * NP1);
        for (int ks = 0; ks < nks; ++ks) {
            const int kb = ks * 128 + wid * 16;
            const bf16x8 ikf = ikn0; ikn0 = ikn1;
            { const int kn = (ks + 2 < nks) ? ks + 2 : nks - 1; ikn1 = *(const bf16x8*)(ikp + (size_t)kn * 128 * NP1); }
            float sc[2][4]; idx_scores(ikf, iq, iw, iql, sc);
            const bool chk = (ks == nks - 1);
#pragma unroll
            for (int qt = 0; qt < 2; ++qt) {
                const int tq = qt ? tq1 : tq0; const float loe = qt ? lo1 : lo0, hie = qt ? hi1 : hi0; const int q = qt * 16 + lr;
                unsigned b = 0u;
#pragma unroll
                for (int j = 0; j < 4; ++j) {
                    const int key = kb + lg * 4 + j;
                    const float sv = sc[qt][j];
                    const bool causal = !chk || (key <= tq);
                    const bool above = sv >= hie;
                    b |= (causal && above) ? (1u << (lg * 4 + j)) : 0u;
                    if (causal && !above && sv >= loe) {
                        const unsigned slot = __hip_atomic_fetch_add(&cc[q], 1u, __ATOMIC_RELAXED, __HIP_MEMORY_SCOPE_WORKGROUP);
                        if (slot < (unsigned)ICAP) { KL[q * ICAP + slot] = mono_key(sv); IL[q * ICAP + slot] = (unsigned short)key; }
                    }
                }
                b |= __shfl_xor(b, 16); b |= __shfl_xor(b, 32);
                if (lg == 0) *(LAS unsigned short*)(LM + q * 1024 + (ks * 8 + wid) * 2) = (unsigned short)b;
            }
        }
    }
    __syncthreads();
    if (tid < 32 && cc[tid] > (unsigned)ICAP) *ovf = 1u;
    __syncthreads();
    if (*ovf != 0u) return false;
    for (int r = 0; r < 4; ++r) {
        const int row = wid * 4 + r; const int n = (int)cc[row]; const int tb = tbin[row];
        if (tb < 0 || n == 0) continue;
        unsigned need = need1[row], pfx = 0u, cnt_eq = 0u;
        LAS unsigned* hh = hist2 + wid * 128;
#pragma unroll 1
        for (int rp = 0; rp < 3; ++rp) {
            const int shift = 14 - 7 * rp;
            hh[lane] = 0u; hh[64 + lane] = 0u;
            __builtin_amdgcn_wave_barrier();
            for (int e = lane; e < n; e += 64) {
                const unsigned k = KL[row * ICAP + e] & 0x1fffffu;
                if (rp == 0 || (k >> (shift + 7)) == pfx) __hip_atomic_fetch_add(&hh[(k >> shift) & 127u], 1u, __ATOMIC_RELAXED, __HIP_MEMORY_SCOPE_WORKGROUP);
            }
            __builtin_amdgcn_wave_barrier();
            const unsigned c_hi = hh[127 - 2 * lane], c_lo = hh[126 - 2 * lane];
            __builtin_amdgcn_wave_barrier();
            int L; unsigned ex; wave_find(c_hi + c_lo, need, lane, L, ex);
            const unsigned chiL = __shfl(c_hi, L), cloL = __shfl(c_lo, L);
            unsigned rem = need - ex; unsigned digit;
            if (rem <= chiL) { digit = 127u - 2u * (unsigned)L; cnt_eq = chiL; } else { digit = 126u - 2u * (unsigned)L; rem -= chiL; cnt_eq = cloL; }
            pfx = (pfx << 7) | digit; need = rem;
        }
        for (int e = lane; e < n; e += 64) {
            const unsigned k = KL[row * ICAP + e] & 0x1fffffu; const unsigned idx = IL[row * ICAP + e];
            bool sel = k > pfx;
            if (k == pfx) {
                if (cnt_eq <= need) sel = true;
                else { unsigned rank = 0u; for (int e2 = 0; e2 < n; ++e2) { const unsigned k2 = KL[row * ICAP + e2] & 0x1fffffu; const unsigned i2 = IL[row * ICAP + e2]; rank += (k2 == pfx && i2 < idx) ? 1u : 0u; } sel = rank < need; }
            }
            if (sel) __hip_atomic_fetch_or((LAS unsigned*)(LM + row * 1024) + (idx >> 5), 1u << (idx & 31u), __ATOMIC_RELAXED, __HIP_MEMORY_SCOPE_WORKGROUP);
        }
    }
    __syncthreads();
    for (int c = tid; c < 32 * nks; c += NTHREADS) { const int row = c / nks, ch = c % nks; *(u32x4*)(MASKB + (rowbase + q0 + row) * 1024 + ch * 16) = *(const LAS u32x4*)(LM + row * 1024 + ch * 16); }
    __syncthreads();
    return true;
}

struct AttnArgs {
    const bf16_t* q; long q_rs; const bf16_t* k; long k_rs; const bf16_t* v; long v_rs;
    int i0; int maxdist; float bound; float l_init;
    const unsigned long long* mask;
    bf16_t* o; long o_rs; const bf16_t* z; long z_rs; float* md; long md_rs;
};
template <int DQK, int VAR>
__device__ __forceinline__ void attn_tile(const LAS bf16_t* sK, const LAS bf16_t* sVt, const LAS float* sBias, const bf16x8 (&qf)[2][DQK / 32], f32x4 (&o)[2][4], float (&lsum)[2],
                                          int qi, int key0, int maxdist, const unsigned (&mlo)[2], const unsigned (&mhi)[2], float sinit, int lr, int lg) {
    constexpr int KP = DQK + 8, VP = 72;
    f32x4 s[2][4];
    u32x4 vfr[2][4];
#pragma unroll
    for (int ch = 0; ch < 2; ++ch) {
        bf16x8 kfr[2][DQK / 32];
#pragma unroll
        for (int c = 0; c < 2; ++c)
#pragma unroll
            for (int ks = 0; ks < DQK / 32; ++ks) kfr[c][ks] = *(const LAS bf16x8*)(sK + ((ch * 2 + c) * 16 + lr) * KP + ks * 32 + lg * 8);
        __builtin_amdgcn_sched_barrier(0);
        __builtin_amdgcn_s_setprio(1);
#pragma unroll
        for (int c = 0; c < 2; ++c) {
            s[0][ch * 2 + c] = (f32x4){sinit, sinit, sinit, sinit}; s[1][ch * 2 + c] = s[0][ch * 2 + c];
#pragma unroll
            for (int ks = 0; ks < DQK / 32; ++ks) {
                s[0][ch * 2 + c] = __builtin_amdgcn_mfma_f32_16x16x32_bf16(kfr[c][ks], qf[0][ks], s[0][ch * 2 + c], 0, 0, 0);
                s[1][ch * 2 + c] = __builtin_amdgcn_mfma_f32_16x16x32_bf16(kfr[c][ks], qf[1][ks], s[1][ch * 2 + c], 0, 0, 0);
            }
        }
        __builtin_amdgcn_s_setprio(0);
        __builtin_amdgcn_sched_barrier(0);
    }
    __builtin_amdgcn_s_setprio(0);
    __builtin_amdgcn_sched_barrier(0);
#pragma unroll
    for (int kk = 0; kk < 2; ++kk)
#pragma unroll
        for (int dt = 0; dt < 4; ++dt) {
            const LAS bf16_t* vp = sVt + (dt * 16 + lr) * VP + kk * 32 + lg * 4;
            const u32x2 v0 = *(const LAS u32x2*)vp, v1 = *(const LAS u32x2*)(vp + 16);
            vfr[kk][dt].x = v0.x; vfr[kk][dt].y = v0.y; vfr[kk][dt].z = v1.x; vfr[kk][dt].w = v1.y;
        }
    __builtin_amdgcn_sched_barrier(0);
#pragma unroll
    for (int qt = 0; qt < 2; ++qt) {
        const int dq = qi + qt * 16 - key0 - lg * 4;
        const LAS float* bp = sBias + (dq + 33);
        float ps = 0.f;
#pragma unroll
        for (int c = 0; c < 4; ++c)
#pragma unroll
            for (int j = 0; j < 4; ++j) {
                float val = s[qt][c][j]; float pv;
                if (VAR == 0) pv = fexp2(val);
                else if (VAR == 1) { pv = fexp2(val); pv = (dq >= c * 16 + j) ? pv : 0.f; }
                else if (VAR == 2) { pv = fexp2(val + bp[63 - (c * 16 + j)]); }
                else if (VAR == 3) { pv = fexp2(val); pv = __uint_as_float(__float_as_uint(pv) & (unsigned)__builtin_amdgcn_sbfe((int)(c < 2 ? mlo[qt] : mhi[qt]), (c & 1) * 16 + j, 1)); }
                else { pv = fexp2(val + bp[63 - (c * 16 + j)]); pv = __uint_as_float(__float_as_uint(pv) & (unsigned)__builtin_amdgcn_sbfe((int)(c < 2 ? mlo[qt] : mhi[qt]), (c & 1) * 16 + j, 1)); }
                s[qt][c][j] = pv; ps += pv;
            }
        lsum[qt] += ps;
    }
    __builtin_amdgcn_s_setprio(1);
#pragma unroll
    for (int kk = 0; kk < 2; ++kk) {
        bf16x8 pb[2];
#pragma unroll
        for (int qt = 0; qt < 2; ++qt) {
            u32x4 pw; pw.x = pk2(s[qt][2 * kk][0], s[qt][2 * kk][1]); pw.y = pk2(s[qt][2 * kk][2], s[qt][2 * kk][3]); pw.z = pk2(s[qt][2 * kk + 1][0], s[qt][2 * kk + 1][1]); pw.w = pk2(s[qt][2 * kk + 1][2], s[qt][2 * kk + 1][3]);
            pb[qt] = __builtin_bit_cast(bf16x8, pw);
        }
#pragma unroll
        for (int dt = 0; dt < 4; ++dt) {
            const bf16x8 vf = __builtin_bit_cast(bf16x8, vfr[kk][dt]);
            o[0][dt] = __builtin_amdgcn_mfma_f32_16x16x32_bf16(vf, pb[0], o[0][dt], 0, 0, 0);
            o[1][dt] = __builtin_amdgcn_mfma_f32_16x16x32_bf16(vf, pb[1], o[1][dt], 0, 0, 0);
        }
    }
    __builtin_amdgcn_s_setprio(0);
}
template <int DQK, int MODE>
__device__ __forceinline__ void attn_unit(LAS unsigned char* lds, const AttnArgs& a, const unsigned char* lut) {
    constexpr int KP = DQK + 8, VP = 72, KCH = DQK / 8;
    const LAS float* sBias = (const LAS float*)(lds + 49152);
    LAS unsigned char* sUni = (LAS unsigned char*)(lds + 83968);
    const int tid = otid(), wid = __builtin_amdgcn_readfirstlane(tid >> 6), lane = tid & 63, lr = lane & 15, lg = lane >> 4;
    const int i0 = a.i0; const int qi = i0 + wid * 32 + lr;
    const int kt_hi = (i0 + 255) >> 6;
    int kt_lo = 0;
    if (MODE == 1) { const int lo = i0 - a.maxdist; kt_lo = lo > 0 ? (lo >> 6) : 0; }
    const int wq_min = i0 + wid * 32, wq_max = wq_min + 31;
    if (MODE == 2) {
        for (int e = tid; e < 8 * (kt_hi + 1); e += NTHREADS) {
            const int w = e / (kt_hi + 1), kt = e % (kt_hi + 1);
            const int dmin = i0 + w * 32 - (kt * 64 + 63), dmax = i0 + w * 32 + 31 - kt * 64;
            sUni[w * 132 + kt] = (dmin >= 0 && lut[dmin] == lut[dmax]) ? 1 : 0;
        }
    }
    bf16x8 qf[2][DQK / 32];
#pragma unroll
    for (int qt = 0; qt < 2; ++qt)
#pragma unroll
        for (int ks = 0; ks < DQK / 32; ++ks) qf[qt][ks] = *(const bf16x8*)(a.q + (long)(qi + qt * 16) * a.q_rs + ks * 32 + lg * 8);
    float lsum[2]; lsum[0] = (lg == 0) ? a.l_init : 0.f; lsum[1] = lsum[0];
    const float nb = -a.bound;
    f32x4 o[2][4];
#pragma unroll
    for (int qt = 0; qt < 2; ++qt)
#pragma unroll
        for (int d = 0; d < 4; ++d) o[qt][d] = (f32x4){0.f, 0.f, 0.f, 0.f};
    u32x4 rk0, rk1; u32x2 rv0, rv1;
    const int kkey0 = tid / KCH, kpart0 = tid % KCH; const int kkey1 = (tid + 512) / KCH, kpart1 = (tid + 512) % KCH;
    const int vkp = tid & 31, vdg = tid >> 5;
#define ATT_LOAD(kt) do { const long kb_ = (long)(kt) * 64; \
        rk0 = *(const u32x4*)(a.k + (kb_ + kkey0) * a.k_rs + kpart0 * 8); \
        if (DQK == 96 && tid < 256) rk1 = *(const u32x4*)(a.k + (kb_ + kkey1) * a.k_rs + kpart1 * 8); \
        rv0 = *(const u32x2*)(a.v + (kb_ + 2 * vkp) * a.v_rs + vdg * 4); rv1 = *(const u32x2*)(a.v + (kb_ + 2 * vkp + 1) * a.v_rs + vdg * 4); } while (0)
#define ATT_STORE(buf) do { LAS bf16_t* sK_ = (LAS bf16_t*)(lds + (buf) * 24576); LAS bf16_t* sV_ = (LAS bf16_t*)(lds + (buf) * 24576 + 14336); \
        *(LAS u32x4*)(sK_ + kkey0 * KP + kpart0 * 8) = rk0; \
        if (DQK == 96 && tid < 256) *(LAS u32x4*)(sK_ + kkey1 * KP + kpart1 * 8) = rk1; \
        *(LAS unsigned*)(sV_ + (vdg * 4 + 0) * VP + 2 * vkp) = (rv0.x & 0xffffu) | (rv1.x << 16); \
        *(LAS unsigned*)(sV_ + (vdg * 4 + 1) * VP + 2 * vkp) = (rv0.x >> 16) | (rv1.x & 0xffff0000u); \
        *(LAS unsigned*)(sV_ + (vdg * 4 + 2) * VP + 2 * vkp) = (rv0.y & 0xffffu) | (rv1.y << 16); \
        *(LAS unsigned*)(sV_ + (vdg * 4 + 3) * VP + 2 * vkp) = (rv0.y >> 16) | (rv1.y & 0xffff0000u); } while (0)
    ATT_LOAD(kt_lo);
    ATT_STORE(0);
    if (kt_lo < kt_hi) ATT_LOAD(kt_lo + 1);
    unsigned long long mwn0 = 0ull, mwn1 = 0ull;
    if (MODE == 2) { mwn0 = a.mask[(long)qi * 128 + kt_lo]; mwn1 = a.mask[(long)(qi + 16) * 128 + kt_lo]; }
    __syncthreads();
    for (int kt = kt_lo; kt <= kt_hi; ++kt) {
        const int cur = (kt - kt_lo) & 1;
        if (kt < kt_hi) ATT_STORE(cur ^ 1);
        if (kt + 1 < kt_hi) ATT_LOAD(kt + 2);
        const unsigned long long mwc0 = mwn0, mwc1 = mwn1;
        if (MODE == 2 && kt < kt_hi) { mwn0 = a.mask[(long)qi * 128 + kt + 1]; mwn1 = a.mask[(long)(qi + 16) * 128 + kt + 1]; }
        const LAS bf16_t* sK = (const LAS bf16_t*)(lds + cur * 24576); const LAS bf16_t* sVt = (const LAS bf16_t*)(lds + cur * 24576 + 14336);
        const int key0 = kt * 64;
        bool skip = key0 > wq_max;
        if (MODE == 1) skip = skip || (key0 + 63 < wq_min - a.maxdist);
        if (!skip) {
            unsigned mlo[2] = {0u, 0u}, mhi[2] = {0u, 0u};
            if (MODE == 0) {
                if (key0 + 63 <= wq_min) attn_tile<DQK, 0>(sK, sVt, sBias, qf, o, lsum, qi, key0, 0, mlo, mhi, nb, lr, lg);
                else attn_tile<DQK, 1>(sK, sVt, sBias, qf, o, lsum, qi, key0, 0, mlo, mhi, nb, lr, lg);
            } else if (MODE == 1) {
                attn_tile<DQK, 2>(sK, sVt, sBias, qf, o, lsum, qi, key0, a.maxdist, mlo, mhi, nb, lr, lg);
            } else {
                const unsigned long long w0 = mwc0 >> (lg * 4), w1 = mwc1 >> (lg * 4);
                mlo[0] = (unsigned)w0; mhi[0] = (unsigned)(w0 >> 32); mlo[1] = (unsigned)w1; mhi[1] = (unsigned)(w1 >> 32);
                const int uni = __builtin_amdgcn_readfirstlane((int)sUni[wid * 132 + kt]);
                if (uni) { const float ub = sBias[96 + wq_min - key0]; attn_tile<DQK, 3>(sK, sVt, sBias, qf, o, lsum, qi, key0, 0, mlo, mhi, nb + ub, lr, lg); }
                else attn_tile<DQK, 4>(sK, sVt, sBias, qf, o, lsum, qi, key0, 0, mlo, mhi, nb, lr, lg);
            }
        }
        __syncthreads();
    }
#undef ATT_LOAD
#undef ATT_STORE
#pragma unroll
    for (int qt = 0; qt < 2; ++qt) {
        const int qr = qi + qt * 16;
        float lt = lsum[qt]; lt += __shfl_xor(lt, 16); lt += __shfl_xor(lt, 32);
        const float inv = 1.0f / lt;
        u32x2 zw[4];
#pragma unroll
        for (int dt = 0; dt < 4; ++dt) zw[dt] = (u32x2){0x3f803f80u, 0x3f803f80u};
        if (a.z) {
#pragma unroll
            for (int dt = 0; dt < 4; ++dt) zw[dt] = *(const u32x2*)(a.z + (long)qr * a.z_rs + dt * 16 + lg * 4);
        }
#pragma unroll
        for (int dt = 0; dt < 4; ++dt) {
            float r[4];
#pragma unroll
            for (int j = 0; j < 4; ++j) r[j] = o[qt][dt][j] * inv;
            const int col = dt * 16 + lg * 4;
            if (a.z) {
                r[0] *= silu_f(__uint_as_float(zw[dt].x << 16)); r[1] *= silu_f(__uint_as_float(zw[dt].x & 0xffff0000u));
                r[2] *= silu_f(__uint_as_float(zw[dt].y << 16)); r[3] *= silu_f(__uint_as_float(zw[dt].y & 0xffff0000u)); }
            u32x2 w; w.x = pk2(r[0], r[1]); w.y = pk2(r[2], r[3]);
            *(u32x2*)(a.o + (long)qr * a.o_rs + col) = w;
        }
        if (a.md && lg == 0) { a.md[(long)qr * a.md_rs] = a.bound; a.md[(long)qr * a.md_rs + 1] = lt; }
    }
}

__device__ __forceinline__ float logit_bound(const float* gq, const float* gk, int dim, const float* bias_col, float extra) {
    const int lane = otid() & 63;
    float a = 0.f, b = 0.f, c = 0.f;
    for (int i = lane; i < dim; i += 64) { a = fmaxf(a, fabsf(gq[i])); b = fmaxf(b, fabsf(gk[i])); }
    if (bias_col && lane < 32) c = fabsf(bias_col[lane * NBH]);
#pragma unroll
    for (int o = 1; o < 64; o <<= 1) { a = fmaxf(a, __shfl_xor(a, o)); b = fmaxf(b, __shfl_xor(b, o)); c = fmaxf(c, __shfl_xor(c, o)); }
    return sqrtf((float)dim) * a * b * LOG2E * 1.03f + c * LOG2E + 0.25f + extra;
}

__device__ __forceinline__ void bcombine_phase(const bf16_t* H, const float* MD, bf16_t* YZ, int Tc) {
    const int lane = otid() & 63; const int gw = (obid() * NTHREADS + otid()) >> 6, nw = (gridDim.x * NTHREADS) >> 6;
    const int h = lane >> 3, d0 = (lane & 7) * 8;
    for (int row = gw; row < Tc; row += nw) {
        float mm[3], dd[3];
#pragma unroll
        for (int g = 0; g < 3; ++g) { mm[g] = MD[((size_t)row * 24 + g * 8 + h) * 2]; dd[g] = MD[((size_t)row * 24 + g * 8 + h) * 2 + 1]; }
        const float M = fmaxf(mm[0], fmaxf(mm[1], mm[2]));
        float w[3]; float ws = 0.f;
#pragma unroll
        for (int g = 0; g < 3; ++g) { w[g] = dd[g] * fexp2(mm[g] - M); ws += w[g]; }
        const float inv = 1.0f / ws;
        float acc[8];
#pragma unroll
        for (int i = 0; i < 8; ++i) acc[i] = 0.f;
#pragma unroll
        for (int g = 0; g < 3; ++g) { const u32x4 ow = *(const u32x4*)(H + (size_t)row * NP1 + BQ + g * 512 + h * 64 + d0); float f[8]; unpack8(ow, f);
#pragma unroll
            for (int i = 0; i < 8; ++i) acc[i] += w[g] * inv * f[i]; }
        const u32x4 zw = *(const u32x4*)(H + (size_t)row * NP1 + BZ + h * 64 + d0); float zf[8]; unpack8(zw, zf);
#pragma unroll
        for (int i = 0; i < 8; ++i) acc[i] *= silu_f(zf[i]);
        *(u32x4*)(YZ + (size_t)row * 2048 + 512 + h * 64 + d0) = pack8(acc);
    }
}

__global__ void __launch_bounds__(NTHREADS) mega_fwd(Params p) {
    extern __shared__ __attribute__((aligned(16))) unsigned char lds_raw[];
    LAS unsigned char* lds = (LAS unsigned char*)lds_raw;
    cg::grid_group grid = cg::this_grid();
    const int nbc = p.nbc, Tc = nbc * SEQ, nchunk = NBATCH / nbc;
    const int G = gridDim.x, bx = obid(), tid = otid();

    { LAS unsigned* misc = (LAS unsigned*)(lds + LDS_MISC); if (tid < 16) misc[tid] = 0u; }
    __syncthreads();
    XcdBarrier xb = xcd_barrier_post((unsigned*)(p.ws + 4096), (volatile LAS unsigned*)(lds + LDS_MISC + 32));
    { const WsMap wm = make_map(nbc); setup_phase(p, wm, lds); }
    grid.sync();

#pragma unroll 1
    for (int l = 0; l < DEPTH; ++l) {
        const float* xin = (l == 0) ? p.x : p.out;
        { const WsMap wm = make_map(nbc); p0_phase(xin, p.norm_gain + l * DM, (bf16_t*)(p.ws + wm.xb)); }
        xcd_barrier(xb);
#pragma unroll 1
        for (int ch = 0; ch < nchunk; ++ch) {
#pragma unroll 1
            for (int ph = 0; ph < 13; ++ph) {
                const WsMap wm = make_map(nbc);
                bf16_t* XB = (bf16_t*)(p.ws + wm.xb); bf16_t* H = (bf16_t*)(p.ws + wm.h);
                bf16_t* QC = (bf16_t*)(p.ws + wm.qc); bf16_t* KC = (bf16_t*)(p.ws + wm.kc); bf16_t* KV = (bf16_t*)(p.ws + wm.kv);
                unsigned long long* MASK = (unsigned long long*)(p.ws + wm.mask); float* MD = (float*)(p.ws + wm.md);
                bf16_t* YZ = (bf16_t*)(p.ws + wm.yz); float* MG = (float*)(p.ws + wm.mg); bf16_t* MGb = (bf16_t*)(p.ws + wm.mgb);
                const unsigned char* lut = p.ws + wm.lut;
                const float* biasd = (const float*)(p.ws + wm.biasd); const float* bnd = (const float*)(p.ws + wm.bnd);
                int* ctl = (int*)(p.ws + wm.ctl);
                const size_t tok0 = (size_t)ch * Tc;
                bool do_sync = true;
                if (ph == 0) {
                    pg8::Gemm g{XB + tok0 * DM, (const bf16_t*)(p.ws + wm.winT) + (size_t)l * NP1 * DM, Tc, NP1, DM, DM, 0, 0};
                    pg8::EpiStoreNorm E{H, p.qga + l * 128, p.qgb + l * 128, p.qgd + l * 128, (LAS float*)(lds + LDS_MISC + 6144), p.cq_gain + l * 256, p.ckv_gain + l * 128};
                    pg8::StaticOrder S; S.init(g.M, g.N, G, bx);
#ifndef SK_GS
                    pg8::gemm_phase(lds, g, S, E);
#endif
                } else if (ph == 2 || ph == 3 || ph == 7) {
                    pg8::Gemm g; pg8::EpiStore E;
                    if (ph == 2) { g = pg8::Gemm{H + CQ, (const bf16_t*)(p.ws + wm.wqbT) + (size_t)l * 768 * 256, Tc, 768, 256, NP1, 0, 0}; E = pg8::EpiStore{QC, 768, 0}; do_sync = false; }
                    else if (ph == 3) { g = pg8::Gemm{H + CKV, (const bf16_t*)(p.ws + wm.wkvbT) + (size_t)l * 1024 * 128, Tc, 1024, 128, NP1, 0, 0}; E = pg8::EpiStore{KV, 1024, 0}; }
                    else { g = pg8::Gemm{XB + tok0 * DM, (const bf16_t*)(p.ws + wm.wgT) + (size_t)l * 4096 * DM, Tc, 4096, DM, DM, 0, 0}; E = pg8::EpiStore{H + BQ, NP1, 1}; }
                    pg8::StaticOrder S; S.init(g.M, g.N, G, bx);
#ifndef SK_GS
                    pg8::gemm_phase(lds, g, S, E);
#endif
#ifdef DUP_GS
                    if (ph == 0) pg8::gemm_phase(lds, g, S, E);
#endif
#ifdef DUP_GG
                    if (ph == 7) pg8::gemm_phase(lds, g, S, E);
#endif
#ifdef DUP_GM
                    if (ph == 2 || ph == 3) pg8::gemm_phase(lds, g, S, E);
#endif
                } else if (ph == 1) {
                    do_sync = false;
                } else if (ph == 4) {
                    mla_phase(p, wm, H, QC, KC, KV, Tc, l);
                } else if (ph == 5) {
                    int* ctr = ctl + (l * 4 + ch) * 2;
                    const int n_idx = nbc * 256, n_c = nbc * 8 * 32, n_b = 3 * nbc * 8 * 32, n_d = nbc * 8 * 32;
                    const int n_all = n_idx + n_c + n_b + n_d;
                    for (;;) {
                        int u = next_unit(ctr, lds);
                        if (u >= n_all) break;
                        if (u < n_idx) { const int qb = 255 - u / nbc, bl = u % nbc;
#ifndef SK_IDX
 if (!indexer_fast(lds, H, (unsigned char*)MASK, bl, qb)) indexer_unit(lds, H, (unsigned short*)MASK, bl, qb);
#endif
#ifdef DUP_IDX
 if (!indexer_fast(lds, H, (unsigned char*)MASK, bl, qb)) indexer_unit(lds, H, (unsigned short*)MASK, bl, qb);
#endif
 }
                        else if (u < n_idx + n_c) {
                            u -= n_idx;
                            const int blk = 31 - u / (nbc * 8), rem = u % (nbc * 8), bl = rem / 8, h = rem % 8;
                            AttnArgs a; const size_t r0 = (size_t)bl * SEQ;
                            a.q = QC + r0 * 768 + h * 96; a.q_rs = 768; a.k = KC + r0 * 768 + h * 96; a.k_rs = 768; a.v = KV + r0 * 1024 + h * 128 + 64; a.v_rs = 1024;
                            a.i0 = blk * 256; a.maxdist = 0; a.bound = bnd[l * 4 + 2]; a.l_init = 0.f; a.mask = nullptr;
                            a.o = YZ + r0 * 2048 + 1024 + h * 64; a.o_rs = 2048; a.z = H + r0 * NP1 + CZ + h * 64; a.z_rs = NP1; a.md = nullptr; a.md_rs = 0;
#ifndef SK_C
                            attn_unit<96, 0>(lds, a, lut);
#endif
#ifdef DUP_C
                            attn_unit<96, 0>(lds, a, lut);
#endif
                        } else {
                            u -= n_idx + n_c;
                            AttnArgs a; int dil, bcol;
                            if (u < n_b) {
                                const int g = u / (nbc * 8 * 32); int rem = u % (nbc * 8 * 32);
                                const int bl = rem / (8 * 32); rem %= (8 * 32); const int h = rem / 32; const int rb = rem % 32;
                                dil = (g == 0) ? 1 : (g == 1 ? 4 : 16); const int nblk = 32 / dil; const int r = rb / nblk, blk = rb % nblk;
                                bcol = 8 + g * 8 + h;
                                const size_t r0 = (size_t)bl * SEQ + r;
                                a.q = H + r0 * NP1 + BQ + g * 512 + h * 64; a.q_rs = (long)dil * NP1; a.k = H + r0 * NP1 + BKK + g * 512 + h * 64; a.k_rs = (long)dil * NP1;
                                a.v = H + r0 * NP1 + BV + g * 512 + h * 64; a.v_rs = (long)dil * NP1;
                                a.i0 = blk * 256; a.maxdist = 128; a.bound = bnd[l * 4 + 1]; a.l_init = 0.f; a.mask = nullptr;
                                a.o = H + r0 * NP1 + BQ + g * 512 + h * 64; a.o_rs = (long)dil * NP1; a.z = nullptr; a.z_rs = 0;
                                a.md = MD + (r0 * 24 + g * 8 + h) * 2; a.md_rs = (long)dil * 48;
                            } else {
                                u -= n_b;
                                const int bl = u / (8 * 32); const int rem = u % (8 * 32); const int h = rem / 32, blk = rem % 32;
                                dil = 1; bcol = 32 + h;
                                const size_t r0 = (size_t)bl * SEQ;
                                a.q = H + r0 * NP1 + DQ + h * 64; a.q_rs = NP1; a.k = H + r0 * NP1 + DK + (h >> 2) * 64; a.k_rs = NP1; a.v = H + r0 * NP1 + DV + (h >> 2) * 64; a.v_rs = NP1;
                                a.i0 = blk * 256; a.maxdist = 127; { const float sk = p.sinks[l * 8 + h] * LOG2E; a.bound = bnd[l * 4 + 3] + fmaxf(sk, 0.f); a.l_init = fexp2(sk - a.bound); } a.mask = nullptr;
                                a.o = YZ + r0 * 2048 + 1536 + h * 64; a.o_rs = 2048; a.z = H + r0 * NP1 + DZ + h * 64; a.z_rs = NP1; a.md = nullptr; a.md_rs = 0;
                            }
                            LAS float* sBias = (LAS float*)(lds + 49152); const int t2 = otid();
                            if (t2 < 96 + 129 + 96) { const int d = t2 - 96; sBias[t2] = (d < 0 || d > a.maxdist) ? -INFINITY : biasd[bcol * SEQ + d * dil]; }
#ifndef SK_B
                            attn_unit<64, 1>(lds, a, lut);
#endif
#ifdef DUP_D
                            if (a.md == nullptr) attn_unit<64, 1>(lds, a, lut);
#endif
                        }
                    }
                } else if (ph == 6) {
                    int* ctr = ctl + (l * 4 + ch) * 2 + 1;
                    const int n_a = nbc * 8 * 32;
                    for (;;) {
                        int u = next_unit(ctr, lds);
                        if (u >= n_a) break;
                        const int blk = 31 - u / (nbc * 8), rem = u % (nbc * 8), bl = rem / 8, h = rem % 8;
                        LAS float* sBias = (LAS float*)(lds + 49152); const int t2 = otid();
                        if (t2 < 96) sBias[t2] = 0.f;
                        for (int d = t2 * 4; d < blk * 256 + 256; d += NTHREADS * 4) *(LAS f32x4*)(sBias + 96 + d) = *(const f32x4*)(biasd + h * SEQ + d);
                        AttnArgs a; const size_t r0 = (size_t)bl * SEQ;
                        a.q = H + r0 * NP1 + AQ + h * 64; a.q_rs = NP1; a.k = H + r0 * NP1 + AK + h * 64; a.k_rs = NP1; a.v = H + r0 * NP1 + AV + h * 64; a.v_rs = NP1;
                        a.i0 = blk * 256; a.maxdist = 0; a.bound = bnd[l * 4 + 0]; a.l_init = 0.f; a.mask = MASK + r0 * 128;
                        a.o = YZ + r0 * 2048 + h * 64; a.o_rs = 2048; a.z = H + r0 * NP1 + AZ + h * 64; a.z_rs = NP1; a.md = nullptr; a.md_rs = 0;
#ifndef SK_A
                        attn_unit<64, 2>(lds, a, lut);
#endif
#ifdef DUP_A
                        attn_unit<64, 2>(lds, a, lut);
#endif
                    }
                    bcombine_phase(H, MD, YZ, Tc);
                } else if (ph < 12) {
                    if (ph == 8) {
                        pg8::Gemm g{YZ, (const bf16_t*)(p.ws + wm.wbrT) + (size_t)l * 4 * 1024 * 512, Tc, 1024, 512, 2048, (size_t)512 * 2, (size_t)1024 * 512 * 2};
                        pg8::BatchOrder4 S; S.base.init(Tc, 1024, G, bx);
                        pg8::EpiBranch E{MGb, H + BQ, NP1};
#ifndef SK_GB
                        pg8::gemm_phase(lds, g, S, E);
#endif
                    } else do_sync = false;
                } else {
                    pg8::Gemm g{MGb, (const bf16_t*)(p.ws + wm.woT) + (size_t)l * 1024 * 1024, Tc, 1024, 1024, 1024, 0, 0}; pg8::StaticOrder S; S.init(Tc, 1024, G, bx);
                    pg8::EpiOut E{xin + tok0 * DM, p.out + tok0 * DM};
#ifndef SK_GO
 pg8::gemm_phase(lds, g, S, E);
#endif
                }
                if (do_sync) xcd_barrier(xb);
#ifdef DUP_SYNC
                if (do_sync) xcd_barrier(xb);
#endif
            }
        }
    }
}

extern "C" void kernel_launch(void* const* d_in, const int* in_sizes, int n_in, void* d_out, int out_size, void* d_ws, size_t ws_size, hipStream_t stream) {
    static int grid_blocks = 0;
    if (!grid_blocks) {
        int dev = 0, cus = 0, per_cu = 0;
        hipGetDevice(&dev);
        hipDeviceGetAttribute(&cus, hipDeviceAttributeMultiprocessorCount, dev);
        hipFuncSetAttribute((const void*)mega_fwd, hipFuncAttributeMaxDynamicSharedMemorySize, LDS_BYTES);
        hipOccupancyMaxActiveBlocksPerMultiprocessor(&per_cu, (const void*)mega_fwd, NTHREADS, LDS_BYTES);
        if (per_cu < 1) per_cu = 1;
        if (per_cu > 1) per_cu = 1;
        grid_blocks = cus * per_cu;
    }
    Params p{};
    p.x = (const float*)d_in[0]; p.norm_gain = (const float*)d_in[1]; p.w_in = (const float*)d_in[2]; p.qga = (const float*)d_in[3]; p.qgb = (const float*)d_in[4];
    p.qgc = (const float*)d_in[5]; p.qgd = (const float*)d_in[6]; p.cq_gain = (const float*)d_in[7]; p.ckv_gain = (const float*)d_in[8]; p.w_q_b = (const float*)d_in[9];
    p.w_kv_b = (const float*)d_in[10]; p.sinks = (const float*)d_in[11]; p.rel_bias = (const float*)d_in[12]; p.w_branch = (const float*)d_in[13]; p.w_out = (const float*)d_in[14];
    p.out = (float*)d_out; p.ws = (unsigned char*)d_ws;
    p.nbc = (make_map(2).total <= ws_size) ? 2 : 1; p.pad = 0;
    hipMemsetAsync(d_ws, 0, 32768, stream);
    void* args[] = {&p};
    hipError_t e = hipLaunchCooperativeKernel((const void*)mega_fwd, dim3(grid_blocks), dim3(NTHREADS), args, LDS_BYTES, stream);
    if (e != hipSuccess) fprintf(stderr, "cooperative launch failed: %s (grid %d)\n", hipGetErrorString(e), grid_blocks);
}
```

```cpp
#include <hip/hip_runtime.h>
#include <hip/hip_cooperative_groups.h>
#include <cstdio>
#include <cstdint>
#include <cmath>
namespace cg = cooperative_groups;

#define LAS __attribute__((address_space(3)))
typedef unsigned short bf16_t;
typedef short bf16x8 __attribute__((ext_vector_type(8)));
typedef float f32x4 __attribute__((ext_vector_type(4)));
typedef unsigned u32x4 __attribute__((ext_vector_type(4)));
typedef unsigned u32x2 __attribute__((ext_vector_type(2)));

constexpr int DM = 1024, NBATCH = 4, SEQ = 8192, DEPTH = 4, TT = NBATCH * SEQ;
constexpr int NIN = 13768, NP1 = 9728, NHC = 9672;
constexpr int AQ = 0, AK = 512, AV = 1024, AZ = 1536, AIQ = 2048, AIK = 2304, AIW = 2336;
constexpr int BQ = 2368, BKK = 3904, BV = 5440, BZ = 6976;
constexpr int CKV = 7488, CPE = 7616, CQ = 7680, CZ = 7936;
constexpr int DQ = 8448, DK = 8960, DV = 9088, DZ = 9216;
constexpr int NBH = 40;
constexpr float LOG2E = 1.4426950408889634f;
constexpr int NTHREADS = 512;
constexpr int LDS_BYTES = 147456;
constexpr int LDS_MISC = 131072 + 256;

struct Params {
    const float* x; const float* norm_gain; const float* w_in; const float* qga; const float* qgb; const float* qgc; const float* qgd;
    const float* cq_gain; const float* ckv_gain; const float* w_q_b; const float* w_kv_b; const float* sinks; const float* rel_bias;
    const float* w_branch; const float* w_out;
    float* out; unsigned char* ws;
    int nbc; int pad;
};

struct WsMap { size_t biasd, bnd, ctl, winT, wgT, wbrT, woT, wqbT, wkvbT, lut, rope, xb, h, qc, kc, kv, mask, md, yz, mg, mgb, total; };
__host__ __device__ inline WsMap make_map(int nbc) {
    WsMap m; size_t o = 0; const size_t Tc = (size_t)nbc * SEQ;
    m.ctl = o; o += 32768;
    m.winT = o; o += (size_t)DEPTH * NP1 * DM * 2;
    m.wgT = o; o += (size_t)DEPTH * 4096 * DM * 2;
    m.wbrT = o; o += (size_t)DEPTH * 4 * 1024 * 512 * 2;
    m.woT = o; o += (size_t)DEPTH * 1024 * 1024 * 2;
    m.wqbT = o; o += (size_t)DEPTH * 768 * 256 * 2;
    m.wkvbT = o; o += (size_t)DEPTH * 1024 * 128 * 2;
    m.lut = o; o += 8192;
    m.biasd = o; o += (size_t)NBH * SEQ * 4;
    m.bnd = o; o += 256;
    m.rope = o; o += (size_t)SEQ * 32 * 4;
    m.xb = o; o += (size_t)TT * DM * 2;
    m.h = o; o += Tc * NP1 * 2;
    m.qc = o; o += Tc * 768 * 2;
    m.kc = o; o += Tc * 768 * 2;
    m.kv = o; o += Tc * 1024 * 2;
    m.mask = o; o += Tc * 1024;
    m.md = o; o += Tc * 48 * 4;
    m.yz = o; o += Tc * 2048 * 2;
    m.mg = o; o += Tc * 1024 * 4;
    m.mgb = o; o += Tc * 1024 * 2;
    m.total = o; return m;
}

__device__ __forceinline__ int otid() { int t = __builtin_amdgcn_workitem_id_x(); asm volatile("" : "+v"(t)); return t; }
__device__ __forceinline__ int obid() { int t = __builtin_amdgcn_workgroup_id_x(); asm volatile("" : "+s"(t)); return t; }
__device__ __forceinline__ float bf2f(unsigned h) { return __uint_as_float(h << 16); }
__device__ __forceinline__ unsigned f2bf(float f) { unsigned u = __float_as_uint(f); return (u + 0x7fffu + ((u >> 16) & 1u)) >> 16; }
typedef float f32x2_t __attribute__((ext_vector_type(2)));
typedef __bf16 bf16x2_t __attribute__((ext_vector_type(2)));
__device__ __forceinline__ unsigned pk2(float lo, float hi) { const f32x2_t v = {lo, hi}; return __builtin_bit_cast(unsigned, __builtin_convertvector(v, bf16x2_t)); }
__device__ __forceinline__ void unpack8(const u32x4 w, float (&f)[8]) {
    f[0] = __uint_as_float(w.x << 16); f[1] = __uint_as_float(w.x & 0xffff0000u);
    f[2] = __uint_as_float(w.y << 16); f[3] = __uint_as_float(w.y & 0xffff0000u);
    f[4] = __uint_as_float(w.z << 16); f[5] = __uint_as_float(w.z & 0xffff0000u);
    f[6] = __uint_as_float(w.w << 16); f[7] = __uint_as_float(w.w & 0xffff0000u);
}
__device__ __forceinline__ u32x4 pack8(const float (&f)[8]) { u32x4 w; w.x = pk2(f[0], f[1]); w.y = pk2(f[2], f[3]); w.z = pk2(f[4], f[5]); w.w = pk2(f[6], f[7]); return w; }
__device__ __forceinline__ float fexp2(float x) { return __builtin_amdgcn_exp2f(x); }
__device__ __forceinline__ float silu_f(float z) { return z * __builtin_amdgcn_rcpf(1.0f + fexp2(-LOG2E * z)); }
__device__ __forceinline__ float sigmoid_f(float z) { return __builtin_amdgcn_rcpf(1.0f + fexp2(-LOG2E * z)); }
__device__ __forceinline__ int t5_bucket_dev(int d) {
    if (d < 16) return d < 0 ? 0 : d;
    const float logd = logf((float)d / 16.0f);
    int large = 16 + (int)(logd / 4.852030263919617f * 16.0f);
    return large < 31 ? large : 31;
}

namespace pg8 {
constexpr int BM = 256, BK = 64, HALF = 128, HTB = HALF * BK * 2, NXCD = 8, WGM = 8;
__host__ __device__ __forceinline__ int lds_byte(int r, int c) { const int st = (r >> 4) * 2 + (c >> 5), rr = r & 15, cc = c & 31, ob = rr * 64 + cc * 2; return st * 1024 + (ob ^ (((ob >> 9) & 1) << 5)); }
__host__ __device__ __forceinline__ void stage_rc(int b, int& R, int& C) { const int st = b / 1024, sb = b % 1024, swz = sb ^ (((sb >> 9) & 1) << 5); R = (st >> 1) * 16 + swz / 64; C = (st & 1) * 32 + (swz % 64) / 2; }
__host__ __device__ __forceinline__ int perm32(int rho) { const int n = rho >> 4, i = rho & 15; return 8 * (i >> 2) + 4 * n + (i & 3); }
struct Unit { int pm, pn, pb; };
struct Gemm { const bf16_t* A; const bf16_t* Bt; int M, N, K, lda; size_t bstepA, bstepB; };
struct StaticOrder {
    int nM, nN, nwg, G, c;
    __host__ __device__ __forceinline__ void init(int M, int N, int G_, int c_) { nM = M / BM; nN = N / BM; nwg = nM * nN; G = G_; c = c_; }
    __host__ __device__ bool next(int i, Unit& u) const {
        const long L = (long)i * G + c; if (L >= nwg) return false;
        int wgid = (int)L; { const int q = nwg / NXCD, r = nwg % NXCD, xcd = wgid % NXCD, off = wgid / NXCD; wgid = (xcd < r ? xcd * (q + 1) : r * (q + 1) + (xcd - r) * q) + off; }
        const int nig = WGM * nN, gid = wgid / nig, fm = gid * WGM, gsz = (nM - fm) < WGM ? (nM - fm) : WGM;
        u.pm = fm + ((wgid % nig) % gsz); u.pn = (wgid % nig) / gsz; u.pb = 0; return true;
    }
    __device__ __forceinline__ void a_ready(const Unit&) const {}
    __device__ __forceinline__ void done(const Unit&) const {}
};
struct BatchOrder4 {
    StaticOrder base;
    __device__ __forceinline__ bool next(int i, Unit& u) const { if (!base.next(i >> 2, u)) return false; u.pb = i & 3; return true; }
    __device__ __forceinline__ void a_ready(const Unit&) const {}
    __device__ __forceinline__ void done(const Unit&) const {}
};
template <class Epi, class Sched>
__device__ __forceinline__ void gemm_phase(LAS unsigned char* lds, const Gemm g, const Sched& S, const Epi& E) {
    const int tid = otid(), wid = __builtin_amdgcn_readfirstlane(tid >> 6), lane = tid & 63, wr = wid >> 2, wc = wid & 3, fr = lane & 15, fq = lane >> 4;
    const int K = g.K, nt = K / BK, lda = g.lda;
    unsigned voffA[2], voffB[2];
#pragma unroll
    for (int i = 0; i < 2; ++i) { int R, C; stage_rc(tid * 16 + i * 8192, R, C); const int Rb = (R & ~31) + perm32(R & 31);
        voffA[i] = (unsigned)(R * lda + C) * 2u; voffB[i] = (unsigned)(Rb * K + C) * 2u; }
    const size_t kstep = (size_t)(BK * 2);
    const size_t hstepA = (size_t)HALF * lda * 2, hstepB = (size_t)HALF * K * 2;
    const size_t tstepA = 2 * hstepA, tstepB = 2 * hstepB;
    const unsigned ldsw = (unsigned)wid * 1024u;
    const int aoff = lds_byte(wr * 64 + fr, fq * 8), boff = lds_byte(wc * 32 + fr, fq * 8);
#define PG8_SA(b, h) (((b) * 2 + (h)) * HTB)
#define PG8_SB(b, h) ((4 + (b) * 2 + (h)) * HTB)
#define PG8_STAGE(bufoff, gbase, voff) do { _Pragma("unroll") for (int _i = 0; _i < 2; ++_i) \
        __builtin_amdgcn_global_load_lds((const unsigned*)((const char*)(gbase) + (voff)[_i]), (LAS unsigned*)(lds + (bufoff) + ldsw + _i * 8192), 16, 0, 0); } while (0)
#define PG8_LDA(dst, b, h) do { _Pragma("unroll") for (int m = 0; m < 4; ++m) _Pragma("unroll") for (int k = 0; k < 2; ++k) dst[m][k] = *(const LAS bf16x8*)(lds + PG8_SA(b, h) + aoff + m * 2048 + k * 1024); } while (0)
#define PG8_LDB(dst, b, h) do { _Pragma("unroll") for (int n = 0; n < 2; ++n) _Pragma("unroll") for (int k = 0; k < 2; ++k) dst[n][k] = *(const LAS bf16x8*)(lds + PG8_SB(b, h) + boff + n * 2048 + k * 1024); } while (0)
#define PG8_MMA(ai, bj, At, Bt) do { __builtin_amdgcn_s_setprio(1); _Pragma("unroll") for (int m = 0; m < 4; ++m) _Pragma("unroll") for (int n = 0; n < 2; ++n) _Pragma("unroll") for (int k = 0; k < 2; ++k) \
        acc[ai][bj][m][n] = __builtin_amdgcn_mfma_f32_16x16x32_bf16(Bt[n][k], At[m][k], acc[ai][bj][m][n], 0, 0, 0); __builtin_amdgcn_s_setprio(0); } while (0)
#define PG8_WAIT_V(n) asm volatile("s_waitcnt vmcnt(" #n ")" ::: "memory")
#define PG8_WAIT_L(n) asm volatile("s_waitcnt lgkmcnt(" #n ")" ::: "memory")
#define PG8_BAR __builtin_amdgcn_s_barrier()
#define PG8_SCHED __builtin_amdgcn_sched_barrier(0)
    Unit cur, nxt; int ui = 0;
    if (!S.next(0, cur)) return;
    f32x4 acc[2][2][4][2];
#pragma unroll
    for (int a = 0; a < 2; ++a)
#pragma unroll
        for (int b = 0; b < 2; ++b)
#pragma unroll
            for (int m = 0; m < 4; ++m)
#pragma unroll
                for (int n = 0; n < 2; ++n) acc[a][b][m][n] = (f32x4){0.f, 0.f, 0.f, 0.f};
    bf16x8 At[4][2], B0[2][2], B1[2][2];
    const char* cA = (const char*)g.A + (size_t)cur.pm * tstepA + (size_t)cur.pb * g.bstepA; const char* cB = (const char*)g.Bt + (size_t)cur.pn * tstepB + (size_t)cur.pb * g.bstepB;
    S.a_ready(cur);
    PG8_STAGE(PG8_SB(0, 0), cB, voffB); PG8_STAGE(PG8_SB(0, 1), cB + hstepB, voffB); PG8_STAGE(PG8_SA(0, 0), cA, voffA); PG8_STAGE(PG8_SA(0, 1), cA + hstepA, voffA);
    if (wr == 1) PG8_BAR;
    PG8_WAIT_V(2); PG8_BAR;
    PG8_STAGE(PG8_SB(1, 0), cB + kstep, voffB); PG8_STAGE(PG8_SA(1, 0), cA + kstep, voffA); PG8_STAGE(PG8_SB(1, 1), cB + hstepB + kstep, voffB);
    PG8_WAIT_V(6); PG8_BAR;
    for (;;) {
        const bool has_next = S.next(ui + 1, nxt);
        const char* nA = has_next ? (const char*)g.A + (size_t)nxt.pm * tstepA + (size_t)nxt.pb * g.bstepA : cA; const char* nB = has_next ? (const char*)g.Bt + (size_t)nxt.pn * tstepB + (size_t)nxt.pb * g.bstepB : cB;
        for (int t = 0; t < nt; t += 2) {
            const bool last = (t == nt - 2);
            const char* a1 = cA + (size_t)(t + 1) * kstep;
            const char* a2 = last ? nA : cA + (size_t)(t + 2) * kstep; const char* b2 = last ? nB : cB + (size_t)(t + 2) * kstep;
            const char* a3 = a2 + kstep; const char* b3 = b2 + kstep;
            if (last && has_next) S.a_ready(nxt);
            PG8_LDB(B0, 0, 0); PG8_LDB(B1, 0, 1); PG8_SCHED; PG8_LDA(At, 0, 0); PG8_STAGE(PG8_SA(1, 1), a1 + hstepA, voffA);
            PG8_WAIT_V(8); PG8_WAIT_L(0); PG8_BAR; PG8_MMA(0, 0, At, B0); PG8_MMA(0, 1, At, B1); PG8_BAR; PG8_SCHED;
            PG8_LDA(At, 0, 1); PG8_STAGE(PG8_SB(0, 0), b2, voffB); PG8_STAGE(PG8_SB(0, 1), b2 + hstepB, voffB); PG8_STAGE(PG8_SA(0, 0), a2, voffA);
            PG8_WAIT_V(8); PG8_WAIT_L(0); PG8_BAR; PG8_MMA(1, 0, At, B0); PG8_MMA(1, 1, At, B1); PG8_BAR; PG8_SCHED;
            PG8_LDB(B0, 1, 0); PG8_LDB(B1, 1, 1); PG8_SCHED; PG8_LDA(At, 1, 0); PG8_STAGE(PG8_SA(0, 1), a2 + hstepA, voffA);
            PG8_WAIT_V(8); PG8_WAIT_L(0); PG8_BAR; PG8_MMA(0, 0, At, B0); PG8_MMA(0, 1, At, B1); PG8_BAR; PG8_SCHED;
            PG8_LDA(At, 1, 1); PG8_STAGE(PG8_SB(1, 0), b3, voffB); PG8_STAGE(PG8_SB(1, 1), b3 + hstepB, voffB); PG8_STAGE(PG8_SA(1, 0), a3, voffA);
            PG8_WAIT_V(8); PG8_WAIT_L(0); PG8_BAR; PG8_MMA(1, 0, At, B0); PG8_MMA(1, 1, At, B1); PG8_BAR; PG8_SCHED;
        }
        if (wr == 0) PG8_BAR;
        E(acc, cur, wr, wc, fr, fq); S.done(cur);
        if (!has_next) break;
#pragma unroll
        for (int a = 0; a < 2; ++a)
#pragma unroll
            for (int b = 0; b < 2; ++b)
#pragma unroll
                for (int m = 0; m < 4; ++m)
#pragma unroll
                    for (int n = 0; n < 2; ++n) acc[a][b][m][n] = (f32x4){0.f, 0.f, 0.f, 0.f};
        cur = nxt; cA = nA; cB = nB; ++ui;
        if (wr == 1) PG8_BAR;
    }
    PG8_WAIT_V(0);
    PG8_BAR;
#undef PG8_SA
#undef PG8_SB
#undef PG8_STAGE
#undef PG8_LDA
#undef PG8_LDB
#undef PG8_MMA
#undef PG8_WAIT_V
#undef PG8_WAIT_L
#undef PG8_BAR
#undef PG8_SCHED
}

struct EpiStore {
    bf16_t* O; int ldc; int act;
    __device__ __forceinline__ void operator()(const f32x4 (&acc)[2][2][4][2], const Unit& u, int wr, int wc, int fr, int fq) const {
        const int row0 = u.pm * BM + wr * 64 + fr; const int col0 = u.pn * BM + wc * 32 + 8 * fq;
#pragma unroll
        for (int ai = 0; ai < 2; ++ai)
#pragma unroll
            for (int m = 0; m < 4; ++m) { bf16_t* rowp = O + (size_t)(row0 + ai * HALF + m * 16) * ldc + col0;
#pragma unroll
                for (int bj = 0; bj < 2; ++bj) { f32x4 v0 = acc[ai][bj][m][0], v1 = acc[ai][bj][m][1];
                    if (act == 1) {
#pragma unroll
                        for (int e = 0; e < 4; ++e) { v0[e] = sigmoid_f(v0[e]); v1[e] = sigmoid_f(v1[e]); }
                    }
                    u32x4 w; w.x = pk2(v0[0], v0[1]); w.y = pk2(v0[2], v0[3]); w.z = pk2(v1[0], v1[1]); w.w = pk2(v1[2], v1[3]);
                    *(u32x4*)(rowp + bj * HALF) = w; } }
    }
};
struct EpiStoreNorm {
    bf16_t* O; const float* qga; const float* qgb; const float* qgd; LAS float* P;
    __device__ __forceinline__ void operator()(const f32x4 (&acc)[2][2][4][2], const Unit& u, int wr, int wc, int fr, int fq) const {
        const int wid = wr * 4 + wc;
        const int row0 = u.pm * BM + wr * 64 + fr; const int col0 = u.pn * BM + wc * 32 + 8 * fq;
        const float qs = 0.125f * LOG2E;
        const float* gp[2]; float sc[2];
#pragma unroll
        for (int bj = 0; bj < 2; ++bj) {
            const int c = u.pn * BM + bj * HALF + (wc >> 1) * 64;
            gp[bj] = nullptr; sc[bj] = 1.0f;
            if (c < 512) { gp[bj] = qga; sc[bj] = qs; } else if (c < 1024) gp[bj] = qga + 64;
            else if (c >= BQ && c < BQ + 1536) { gp[bj] = qgb; sc[bj] = qs; } else if (c >= BKK && c < BKK + 1536) gp[bj] = qgb + 64;
            else if (c >= DQ && c < DQ + 512) { gp[bj] = qgd; sc[bj] = qs; } else if (c >= DK && c < DK + 128) gp[bj] = qgd + 64;
        }
        unsigned pown = (unsigned)((wid * 256 + fr) * 4), ppar = (unsigned)(((wid ^ 1) * 256 + fr) * 4);
        asm volatile("" : "+v"(pown), "+v"(ppar));
        LAS unsigned char* Pb = (LAS unsigned char*)P;
#pragma unroll
        for (int ai = 0; ai < 2; ++ai)
#pragma unroll
            for (int m = 0; m < 4; ++m)
#pragma unroll
                for (int bj = 0; bj < 2; ++bj) {
                    const f32x4 v0 = acc[ai][bj][m][0], v1 = acc[ai][bj][m][1];
                    float t = v0[0] * v0[0] + v0[1] * v0[1] + v0[2] * v0[2] + v0[3] * v0[3] + v1[0] * v1[0] + v1[1] * v1[1] + v1[2] * v1[2] + v1[3] * v1[3];
                    t += __shfl_xor(t, 16); t += __shfl_xor(t, 32);
                    if (fq == 0) *(LAS float*)(Pb + pown + ((ai * 4 + m) * 2 + bj) * 64) = t;
                }
        asm volatile("s_waitcnt lgkmcnt(0)" ::: "memory"); __builtin_amdgcn_s_barrier(); asm volatile("" ::: "memory");
#pragma unroll
        for (int bj = 0; bj < 2; ++bj) {
            f32x4 g0 = (f32x4){1.f, 1.f, 1.f, 1.f}, g1 = g0;
            if (gp[bj]) { const float* g = gp[bj] + (wc & 1) * 32 + fq * 8; g0 = *(const f32x4*)g * sc[bj]; g1 = *(const f32x4*)(g + 4) * sc[bj]; }
#pragma unroll
            for (int ai = 0; ai < 2; ++ai)
#pragma unroll
                for (int m = 0; m < 4; ++m) {
                    f32x4 v0 = acc[ai][bj][m][0], v1 = acc[ai][bj][m][1];
                    if (gp[bj]) {
                        const float tot = *(const LAS float*)(Pb + pown + ((ai * 4 + m) * 2 + bj) * 64) + *(const LAS float*)(Pb + ppar + ((ai * 4 + m) * 2 + bj) * 64);
                        const float rs = rsqrtf(tot * (1.0f / 64.0f) + 1e-6f);
#pragma unroll
                        for (int e = 0; e < 4; ++e) { v0[e] = v0[e] * rs * g0[e]; v1[e] = v1[e] * rs * g1[e]; }
                    }
                    u32x4 w; w.x = pk2(v0[0], v0[1]); w.y = pk2(v0[2], v0[3]); w.z = pk2(v1[0], v1[1]); w.w = pk2(v1[2], v1[3]);
                    *(u32x4*)(O + (size_t)(row0 + ai * HALF + m * 16) * NP1 + col0 + bj * HALF) = w;
                    __builtin_amdgcn_sched_barrier(0);
                }
        }
    }
};
struct EpiBranch {
    bf16_t* MGb; const bf16_t* G; int ldg;
    __device__ __forceinline__ void operator()(const f32x4 (&acc)[2][2][4][2], const Unit& u, int wr, int wc, int fr, int fq) const {
        const int row0 = u.pm * BM + wr * 64 + fr; const int col0 = u.pn * BM + wc * 32 + 8 * fq;
        const bf16_t* Gb = G + u.pb * 1024; const bool first = (u.pb == 0);
#pragma unroll
        for (int ai = 0; ai < 2; ++ai)
#pragma unroll
            for (int m = 0; m < 4; ++m) { const size_t row = (size_t)(row0 + ai * HALF + m * 16);
#pragma unroll
                for (int bj = 0; bj < 2; ++bj) { const int col = col0 + bj * HALF;
                    const u32x4 gw = *(const u32x4*)(Gb + row * ldg + col);
                    const u32x4 ow = first ? (u32x4){0u, 0u, 0u, 0u} : *(const u32x4*)(MGb + row * 1024 + col);
                    float gf[8], of[8]; unpack8(gw, gf); unpack8(ow, of);
                    const f32x4 v0 = acc[ai][bj][m][0], v1 = acc[ai][bj][m][1];
#pragma unroll
                    for (int e = 0; e < 4; ++e) { of[e] += v0[e] * gf[e]; of[4 + e] += v1[e] * gf[4 + e]; }
                    *(u32x4*)(MGb + row * 1024 + col) = pack8(of); } }
    }
};
struct EpiOut {
    const float* xin; float* out;
    __device__ __forceinline__ void operator()(const f32x4 (&acc)[2][2][4][2], const Unit& u, int wr, int wc, int fr, int fq) const {
        const int row0 = u.pm * BM + wr * 64 + fr; const int col0 = u.pn * BM + wc * 32 + 8 * fq;
#pragma unroll
        for (int ai = 0; ai < 2; ++ai)
#pragma unroll
            for (int m = 0; m < 4; ++m) { const size_t row = (size_t)(row0 + ai * HALF + m * 16);
#pragma unroll
                for (int bj = 0; bj < 2; ++bj) { const size_t off = row * 1024 + col0 + bj * HALF;
                    const f32x4 x0 = *(const f32x4*)(xin + off), x1 = *(const f32x4*)(xin + off + 4);
                    *(f32x4*)(out + off) = x0 + acc[ai][bj][m][0]; *(f32x4*)(out + off + 4) = x1 + acc[ai][bj][m][1]; } }
    }
};
}


#define XB_TMO      128
#define XB_XCNT(j)  (256  + 64 * (j))
#define XB_XSUB(j)  (1280 + 64 * (j))
#define XB_XGEN(j)  (2304 + 64 * (j))
#define XB_TOP      3328
#define XB_TOPGEN   3392
#define XCD_BAR_WORDS 3456
#define XB_SPIN_CAP (1u << 22)
__device__ __forceinline__ unsigned xb_ld(unsigned* p)              { return __hip_atomic_load(p, __ATOMIC_RELAXED, __HIP_MEMORY_SCOPE_AGENT); }
__device__ __forceinline__ unsigned xb_add(unsigned* p, unsigned v) { return __hip_atomic_fetch_add(p, v, __ATOMIC_RELAXED, __HIP_MEMORY_SCOPE_AGENT); }
__device__ __forceinline__ unsigned xb_xcc_id() { return (unsigned)__builtin_amdgcn_s_getreg((3 << 11) | 20) & 0xFu; }
#define XB_SPIN(cond, bar) do { unsigned _sp = 0; while (cond) { __builtin_amdgcn_s_sleep(1); \
    if ((++_sp & 255u) == 0u) { if (xb_ld(&(bar)[XB_TMO])) break; if (_sp > XB_SPIN_CAP) { atomicAdd(&(bar)[XB_TMO], 1u); break; } } } } while (0)
struct XcdBarrier { unsigned* bar; unsigned x; volatile LAS unsigned* st; };
__device__ __forceinline__ XcdBarrier xcd_barrier_post(unsigned* bar, volatile LAS unsigned* st) {
    XcdBarrier b; b.bar = bar; b.x = xb_xcc_id(); b.st = st;
    if (threadIdx.x == 0) (void)xb_add(&bar[XB_XCNT(b.x)], 1u);
    return b;
}
__device__ __forceinline__ void xcd_barrier_complete(unsigned* bar, unsigned x, unsigned& nloc, unsigned& nx) {
    const unsigned G = gridDim.x * gridDim.y * gridDim.z;
    unsigned sum, cnt, mine, sp = 0u;
    for (;;) {
        sum = 0u; cnt = 0u; mine = 0u;
#pragma unroll
        for (unsigned j = 0; j < 16; ++j) { const unsigned c = xb_ld(&bar[XB_XCNT(j)]); sum += c; cnt += (c > 0u) ? 1u : 0u; mine = (j == x) ? c : mine; }
        if (sum == G) break;
        __builtin_amdgcn_s_sleep(1);
        if ((++sp & 255u) == 0u) { if (xb_ld(&bar[XB_TMO])) break; if (sp > XB_SPIN_CAP) { atomicAdd(&bar[XB_TMO], 1u); break; } }
    }
    nloc = mine > 0u ? mine : 1u; nx = cnt > 0u ? cnt : 1u;
}
__device__ __forceinline__ void xcd_barrier(const XcdBarrier& b) {
    asm volatile("s_waitcnt vmcnt(0)" ::: "memory");
    __syncthreads();
    if (threadIdx.x == 0) {
        unsigned* bar = b.bar;
        __builtin_amdgcn_s_waitcnt(0);
        unsigned nloc = b.st[0], nx = b.st[1];
        if (nloc == 0u) { xcd_barrier_complete(bar, b.x, nloc, nx); b.st[0] = nloc; b.st[1] = nx; }
        const unsigned old = xb_add(&bar[XB_XSUB(b.x)], 1u);
        const unsigned gen = old / nloc;
        if (old + 1u == (gen + 1u) * nloc) {
            __builtin_amdgcn_fence(__ATOMIC_RELEASE, "agent");
            asm volatile("s_waitcnt vmcnt(0)" ::: "memory");
            const unsigned og = xb_add(&bar[XB_TOP], 1u);
            const unsigned tg = og / nx;
            if (og + 1u == (tg + 1u) * nx) xb_add(&bar[XB_TOPGEN], 1u);
            else XB_SPIN(xb_ld(&bar[XB_TOPGEN]) == tg, bar);
            __builtin_amdgcn_fence(__ATOMIC_ACQUIRE, "agent");
            xb_add(&bar[XB_XGEN(b.x)], 1u);
            asm volatile("s_waitcnt vmcnt(0)" ::: "memory");
        } else {
            XB_SPIN(xb_ld(&bar[XB_XGEN(b.x)]) == gen, bar);
            __builtin_amdgcn_fence(__ATOMIC_ACQUIRE, "agent");
            asm volatile("s_waitcnt vmcnt(0)" ::: "memory");
        }
    }
    __syncthreads();
}

__device__ __forceinline__ int next_unit(int* counter, LAS unsigned char* lds) {
    LAS int* slot = (LAS int*)(lds + LDS_MISC);
    __syncthreads();
    if (otid() == 0) *slot = atomicAdd(counter, 1);
    __syncthreads();
    return __builtin_amdgcn_readfirstlane(*slot);
}

__device__ __forceinline__ void tr_tile(LAS unsigned char* lds, const float* src, int pitch, int K, int c0, int nc, bf16_t* dst, int tile) {
    LAS float* T = (LAS float*)lds;
    const int nkt = K / 64; const int kt = tile % nkt, ntl = tile / nkt; const int k0 = kt * 64, n0 = ntl * 64;
    const int tid = otid();
    __syncthreads();
    {
        const int r = (tid >> 4), c4 = (tid & 15) * 4;
        f32x4 v0 = (f32x4){0.f, 0.f, 0.f, 0.f}, v1 = v0;
        if (n0 + c4 + 4 <= nc) { v0 = *(const f32x4*)(src + (size_t)(k0 + r) * pitch + c0 + n0 + c4); v1 = *(const f32x4*)(src + (size_t)(k0 + r + 32) * pitch + c0 + n0 + c4); }
        T[r * 65 + c4 + 0] = v0[0]; T[r * 65 + c4 + 1] = v0[1]; T[r * 65 + c4 + 2] = v0[2]; T[r * 65 + c4 + 3] = v0[3];
        T[(r + 32) * 65 + c4 + 0] = v1[0]; T[(r + 32) * 65 + c4 + 1] = v1[1]; T[(r + 32) * 65 + c4 + 2] = v1[2]; T[(r + 32) * 65 + c4 + 3] = v1[3];
    }
    __syncthreads();
    const int n = tid >> 3, kc = (tid & 7) * 8;
    if (n0 + n < nc) {
        float f[8];
#pragma unroll
        for (int i = 0; i < 8; ++i) f[i] = T[(kc + i) * 65 + n];
        *(u32x4*)(dst + (size_t)(n0 + n) * K + k0 + kc) = pack8(f);
    }
}

__device__ __forceinline__ void setup_phase(const Params& p, const WsMap& wm, LAS unsigned char* lds) {
    constexpr int T_WIN = 16 * 152, T_WG = 16 * 64, T_WBR = 4 * 8 * 16, T_WO = 16 * 16, T_WQB = 4 * 12, T_WKVB = 2 * 16;
    constexpr int T_LAYER = T_WIN + T_WG + T_WBR + T_WO + T_WQB + T_WKVB;
    for (int t = obid(); t < DEPTH * T_LAYER; t += gridDim.x) {
        const int l = t / T_LAYER; int r = t % T_LAYER;
        if (r < T_WIN) {
            const float* src = p.w_in + (size_t)l * DM * NIN; bf16_t* dst = (bf16_t*)(p.ws + wm.winT) + (size_t)l * NP1 * DM;
            int c0, nc, d0, t = r;
            if (t < 16 * 37) { c0 = 0; nc = 2344; d0 = 0; }
            else if ((t -= 16 * 37) < 16 * 80) { c0 = 2344; nc = 5120; d0 = BQ; }
            else if ((t -= 16 * 80) < 16 * 4) { c0 = 7464; nc = 256; d0 = CQ; }
            else if ((t -= 16 * 4) < 16 * 2) { c0 = 7720; nc = 128; d0 = CKV; }
            else if ((t -= 16 * 2) < 16 * 1) { c0 = 7848; nc = 32; d0 = CPE; }
            else if ((t -= 16 * 1) < 16 * 8) { c0 = 7880; nc = 512; d0 = CZ; }
            else { t -= 16 * 8; c0 = 8392; nc = 1280; d0 = DQ; }
            tr_tile(lds, src, NIN, DM, c0, nc, dst + (size_t)d0 * DM, t); continue;
        }
        r -= T_WIN;
        if (r < T_WG) { tr_tile(lds, p.w_in + (size_t)l * DM * NIN, NIN, DM, NHC, 4096, (bf16_t*)(p.ws + wm.wgT) + (size_t)l * 4096 * DM, r); continue; }
        r -= T_WG;
        if (r < T_WBR) { const int b = r / (8 * 16); tr_tile(lds, p.w_branch + ((size_t)l * 4 + b) * 512 * 1024, 1024, 512, 0, 1024, (bf16_t*)(p.ws + wm.wbrT) + ((size_t)l * 4 + b) * 1024 * 512, r % (8 * 16)); continue; }
        r -= T_WBR;
        if (r < T_WO) { tr_tile(lds, p.w_out + (size_t)l * 1024 * 1024, 1024, 1024, 0, 1024, (bf16_t*)(p.ws + wm.woT) + (size_t)l * 1024 * 1024, r); continue; }
        r -= T_WO;
        if (r < T_WQB) { tr_tile(lds, p.w_q_b + (size_t)l * 256 * 768, 768, 256, 0, 768, (bf16_t*)(p.ws + wm.wqbT) + (size_t)l * 768 * 256, r); continue; }
        r -= T_WQB;
        tr_tile(lds, p.w_kv_b + (size_t)l * 128 * 1024, 1024, 128, 0, 1024, (bf16_t*)(p.ws + wm.wkvbT) + (size_t)l * 1024 * 128, r);
    }
    const int gtid = obid() * NTHREADS + otid(), gsz = gridDim.x * NTHREADS;
    unsigned char* lut = p.ws + wm.lut;
    for (int d = gtid; d < SEQ; d += gsz) lut[d] = (unsigned char)t5_bucket_dev(d);
    {
        float* biasd = (float*)(p.ws + wm.biasd);
        for (int e = gtid; e < NBH * SEQ; e += gsz) { const int col = e / SEQ, d = e % SEQ; biasd[e] = p.rel_bias[t5_bucket_dev(d) * NBH + col] * LOG2E; }
        if (obid() == 0 && otid() < 64) {
            const int lane = otid();
            float bm = 0.f;
            for (int i = lane; i < 32 * NBH; i += 64) bm = fmaxf(bm, fabsf(p.rel_bias[i]));
#pragma unroll
            for (int o = 1; o < 64; o <<= 1) bm = fmaxf(bm, __shfl_xor(bm, o));
            float* bnd = (float*)(p.ws + wm.bnd);
            for (int l = 0; l < DEPTH; ++l)
                for (int br = 0; br < 4; ++br) {
                    const float* g = (br == 0) ? p.qga : (br == 1) ? p.qgb : (br == 2) ? p.qgc : p.qgd; const int dim = (br == 2) ? 96 : 64;
                    float a = 0.f, b = 0.f;
                    for (int i = lane; i < dim; i += 64) { a = fmaxf(a, fabsf(g[(l * 2) * dim + i])); b = fmaxf(b, fabsf(g[(l * 2 + 1) * dim + i])); }
#pragma unroll
                    for (int o = 1; o < 64; o <<= 1) { a = fmaxf(a, __shfl_xor(a, o)); b = fmaxf(b, __shfl_xor(b, o)); }
                    if (lane == 0) bnd[l * 4 + br] = sqrtf((float)dim) * a * b * LOG2E * 1.03f + ((br == 2) ? 0.f : bm * LOG2E) + 0.25f;
                }
        }
    }
    float* rope = (float*)(p.ws + wm.rope);
    for (int e = gtid; e < SEQ * 16; e += gsz) {
        const int pos = e >> 4, i = e & 15;
        const float freq = (float)pow(10000.0, -(double)i / 16.0);
        const float ang = (float)pos * freq;
        rope[pos * 32 + i] = (float)cos((double)ang); rope[pos * 32 + 16 + i] = (float)sin((double)ang);
    }
}

__device__ __forceinline__ void p0_phase(const float* xin, const float* gain, bf16_t* xb) {
    const int lane = otid() & 63; const int gw = (obid() * NTHREADS + otid()) >> 6, nw = (gridDim.x * NTHREADS) >> 6;
    f32x4 g[4];
#pragma unroll
    for (int i = 0; i < 4; ++i) g[i] = *(const f32x4*)(gain + i * 256 + lane * 4);
    for (int row = gw; row < TT; row += nw) {
        const float* xr = xin + (size_t)row * DM; f32x4 v[4]; float ss = 0.f;
#pragma unroll
        for (int i = 0; i < 4; ++i) { v[i] = *(const f32x4*)(xr + i * 256 + lane * 4); ss += v[i][0] * v[i][0] + v[i][1] * v[i][1] + v[i][2] * v[i][2] + v[i][3] * v[i][3]; }
#pragma unroll
        for (int o = 1; o < 64; o <<= 1) ss += __shfl_xor(ss, o);
        const float rs = rsqrtf(ss * (1.0f / DM) + 1e-6f);
#pragma unroll
        for (int i = 0; i < 4; ++i) { u32x2 w; w.x = pk2(v[i][0] * rs * g[i][0], v[i][1] * rs * g[i][1]); w.y = pk2(v[i][2] * rs * g[i][2], v[i][3] * rs * g[i][3]);
            *(u32x2*)(xb + (size_t)row * DM + i * 256 + lane * 4) = w; }
    }
}

__device__ __forceinline__ void norm8(u32x4& w, const float (&g)[8], int nl, float inv_gs, bool act) {
    float f[8]; unpack8(w, f); float ss = 0.f;
#pragma unroll
    for (int i = 0; i < 8; ++i) ss += f[i] * f[i];
    if (!act) ss = 0.f;
    ss += __shfl_xor(ss, 1); ss += __shfl_xor(ss, 2); ss += __shfl_xor(ss, 4);
    if (nl > 8) ss += __shfl_xor(ss, 8);
    if (nl > 16) ss += __shfl_xor(ss, 16);
    const float rs = rsqrtf(ss * inv_gs + 1e-6f);
#pragma unroll
    for (int i = 0; i < 8; ++i) f[i] = f[i] * rs * g[i];
    w = pack8(f);
}
__device__ __forceinline__ void norm_phase(const Params& p, bf16_t* H, int Tc, int l) {
    const int lane = otid() & 63; const int gw = (obid() * NTHREADS + otid()) >> 6, nw = (gridDim.x * NTHREADS) >> 6;
    float gCq[8], gCkv[8];
#pragma unroll
    for (int i = 0; i < 8; ++i) { gCq[i] = p.cq_gain[l * 256 + (lane & 31) * 8 + i]; gCkv[i] = p.ckv_gain[l * 128 + (lane & 15) * 8 + i]; }
    const bool isq = lane < 32;
    const bool act = lane < 48;
    for (int row = gw; row < Tc; row += nw) {
        bf16_t* ptr = H + (size_t)row * NP1 + (isq ? CQ + lane * 8 : CKV + (lane - 32) * 8);
        u32x4 w = act ? *(const u32x4*)ptr : (u32x4){0u, 0u, 0u, 0u};
        float f[8]; unpack8(w, f); float ss = 0.f;
#pragma unroll
        for (int i = 0; i < 8; ++i) ss += f[i] * f[i];
        ss += __shfl_xor(ss, 1); ss += __shfl_xor(ss, 2); ss += __shfl_xor(ss, 4); ss += __shfl_xor(ss, 8);
        const float s16 = __shfl_xor(ss, 16);
        if (isq) ss += s16;
        const float rs = rsqrtf(ss * (isq ? (1.0f / 256.0f) : (1.0f / 128.0f)) + 1e-6f);
#pragma unroll
        for (int i = 0; i < 8; ++i) f[i] = f[i] * rs * (isq ? gCq[i] : gCkv[i]);
        if (act) *(u32x4*)ptr = pack8(f);
    }
}

__device__ __forceinline__ void mla_phase(const Params& p, const WsMap& wm, const bf16_t* H, bf16_t* QC, bf16_t* KC, const bf16_t* KV, int Tc, int l) {
    const int lane = otid() & 63; const int gw = (obid() * NTHREADS + otid()) >> 6, nw = (gridDim.x * NTHREADS) >> 6;
    const float* rope = (const float*)(p.ws + wm.rope);
    const int sub = lane & 15, hl = lane >> 4;
    const float qscale = 0.10206207261596577f * LOG2E;
    const bool act = sub < 12; const int gsub = act ? sub : 0;
    float gq[8], gk[8];
#pragma unroll
    for (int i = 0; i < 8; ++i) { gq[i] = p.qgc[(l * 2 + 0) * 96 + gsub * 8 + i] * qscale; gk[i] = p.qgc[(l * 2 + 1) * 96 + gsub * 8 + i]; }
    for (int row = gw; row < Tc; row += nw) {
        const int pos = row & (SEQ - 1);
        u32x4 w[4];
#pragma unroll
        for (int part = 0; part < 4; ++part) {
            const int isk = part >> 1, h = (part & 1) * 4 + hl;
            w[part] = (u32x4){0u, 0u, 0u, 0u};
            if (act) {
                if (!isk) w[part] = *(const u32x4*)(QC + (size_t)row * 768 + h * 96 + sub * 8);
                else if (sub < 8) w[part] = *(const u32x4*)(KV + (size_t)row * 1024 + h * 128 + sub * 8);
                else w[part] = *(const u32x4*)(H + (size_t)row * NP1 + CPE + (sub - 8) * 8);
            }
        }
        const float* cs = rope + pos * 32 + (sub & 1) * 8;
        const f32x4 c0 = *(const f32x4*)cs, c1 = *(const f32x4*)(cs + 4), s0 = *(const f32x4*)(cs + 16), s1 = *(const f32x4*)(cs + 20);
        const float cc[8] = {c0[0], c0[1], c0[2], c0[3], c1[0], c1[1], c1[2], c1[3]};
        const float sn[8] = {s0[0], s0[1], s0[2], s0[3], s1[0], s1[1], s1[2], s1[3]};
#pragma unroll
        for (int part = 0; part < 4; ++part) {
            const int isk = part >> 1, h = (part & 1) * 4 + hl;
            float f[8]; unpack8(w[part], f); float ss = 0.f;
#pragma unroll
            for (int i = 0; i < 8; ++i) ss += f[i] * f[i];
            ss += __shfl_xor(ss, 1); ss += __shfl_xor(ss, 2); ss += __shfl_xor(ss, 4); ss += __shfl_xor(ss, 8);
            const float rs = rsqrtf(ss * (1.0f / 96.0f) + 1e-6f);
#pragma unroll
            for (int i = 0; i < 8; ++i) f[i] = f[i] * rs * (isk ? gk[i] : gq[i]);
#pragma unroll
            for (int i = 0; i < 8; ++i) {
                const float other = __shfl_xor(f[i], 2);
                if (sub >= 8 && sub < 12) f[i] = (sub < 10) ? (f[i] * cc[i] - other * sn[i]) : (f[i] * cc[i] + other * sn[i]);
            }
            if (act) { bf16_t* dst = (isk ? KC : QC) + (size_t)row * 768 + h * 96 + sub * 8; *(u32x4*)dst = pack8(f); }
        }
    }
}

__device__ __forceinline__ void indexer_unit(LAS unsigned char* lds, const bf16_t* H, unsigned short* MASK16, int bl, int qb) {
    LAS unsigned* hist = (LAS unsigned*)lds;
    LAS unsigned* prefix = (LAS unsigned*)(lds + 32768);
    LAS unsigned* need = (LAS unsigned*)(lds + 32768 + 128);
    const int tid = otid(), wid = __builtin_amdgcn_readfirstlane(tid >> 6), lane = tid & 63, lr = lane & 15, lg = lane >> 4;
    const int q0 = qb * 32; const size_t rowbase = (size_t)bl * SEQ;
    const int nks = (q0 + 31) / 128 + 1;
    __syncthreads();
    if (tid < 32) { prefix[tid] = 0u; need[tid] = 256u; }
    bf16x8 iq[2][8]; float iw[2][8];
#pragma unroll
    for (int qt = 0; qt < 2; ++qt) {
        const bf16_t* hr = H + (rowbase + q0 + qt * 16 + lr) * NP1;
#pragma unroll
        for (int h = 0; h < 8; ++h) iq[qt][h] = *(const bf16x8*)(hr + AIQ + h * 32 + lg * 8);
        const u32x4 w = *(const u32x4*)(hr + AIW); float f[8]; unpack8(w, f);
#pragma unroll
        for (int h = 0; h < 8; ++h) iw[qt][h] = f[h];
    }
    const int tq0 = q0 + lr, tq1 = q0 + 16 + lr;
    for (int pass = 0; pass < 5; ++pass) {
        if (pass < 4) { for (int i = tid; i < 32 * 256; i += NTHREADS) hist[i] = 0u; }
        __syncthreads();
        const unsigned pf0 = prefix[lr], pf1 = prefix[16 + lr];
        const unsigned th0 = (tq0 < 256) ? 0u : pf0, th1 = (tq1 < 256) ? 0u : pf1;
        const int shp = (pass == 0) ? 0 : (32 - 8 * pass), shd = (pass < 4) ? (24 - 8 * pass) : 0;
        for (int ks = 0; ks < nks; ++ks) {
            const int kb = ks * 128 + wid * 16;
            const bf16x8 ikf = *(const bf16x8*)(H + (rowbase + kb + lr) * NP1 + AIK + lg * 8);
            float sc[2][4];
#pragma unroll
            for (int qt = 0; qt < 2; ++qt) {
#pragma unroll
                for (int j = 0; j < 4; ++j) sc[qt][j] = 0.f;
#pragma unroll
                for (int h = 0; h < 8; ++h) {
                    f32x4 a = (f32x4){0.f, 0.f, 0.f, 0.f};
                    a = __builtin_amdgcn_mfma_f32_16x16x32_bf16(ikf, iq[qt][h], a, 0, 0, 0);
#pragma unroll
                    for (int j = 0; j < 4; ++j) sc[qt][j] += iw[qt][h] * fmaxf(a[j], 0.f);
                }
            }
            if (pass < 4) {
#pragma unroll
                for (int qt = 0; qt < 2; ++qt) {
                    const int tq = qt ? tq1 : tq0; const unsigned pf = qt ? pf1 : pf0;
#pragma unroll
                    for (int j = 0; j < 4; ++j) {
                        const int key = kb + lg * 4 + j;
                        const unsigned u = __float_as_uint(sc[qt][j] + 0.0f);
                        const unsigned k32 = (u & 0x80000000u) ? ~u : (u | 0x80000000u);
                        const bool ok = (key <= tq) && (pass == 0 || (k32 >> shp) == pf);
                        if (ok) __hip_atomic_fetch_add(&hist[(qt * 16 + lr) * 256 + ((k32 >> shd) & 255u)], 1u, __ATOMIC_RELAXED, __HIP_MEMORY_SCOPE_WORKGROUP);
                    }
                }
            } else {
                unsigned bits[2];
#pragma unroll
                for (int qt = 0; qt < 2; ++qt) {
                    const int tq = qt ? tq1 : tq0; const unsigned th = qt ? th1 : th0;
                    unsigned b = 0u;
#pragma unroll
                    for (int j = 0; j < 4; ++j) {
                        const int key = kb + lg * 4 + j;
                        const unsigned u = __float_as_uint(sc[qt][j] + 0.0f);
                        const unsigned k32 = (u & 0x80000000u) ? ~u : (u | 0x80000000u);
                        if ((key <= tq) && (k32 >= th)) b |= 1u << (lg * 4 + j);
                    }
                    b |= __shfl_xor(b, 16); b |= __shfl_xor(b, 32);
                    bits[qt] = b;
                }
                if (lg == 0) {
                    MASK16[(rowbase + tq0) * 512 + ks * 8 + wid] = (unsigned short)bits[0];
                    MASK16[(rowbase + tq1) * 512 + ks * 8 + wid] = (unsigned short)bits[1];
                }
            }
        }
        if (pass < 4) {
            __syncthreads();
            for (int r = 0; r < 4; ++r) {
                const int row = wid * 4 + r;
                const unsigned c0 = hist[row * 256 + 255 - 4 * lane], c1 = hist[row * 256 + 254 - 4 * lane], c2 = hist[row * 256 + 253 - 4 * lane], c3 = hist[row * 256 + 252 - 4 * lane];
                const unsigned cs = c0 + c1 + c2 + c3; unsigned incl = cs;
#pragma unroll
                for (int o = 1; o < 64; o <<= 1) { const unsigned t = __shfl_up(incl, o); if (lane >= o) incl += t; }
                const unsigned excl = incl - cs; const unsigned nd = need[row];
                if (excl < nd && nd <= incl) {
                    unsigned a = excl; int dg; unsigned nn;
                    if (a + c0 >= nd) { dg = 255 - 4 * lane; nn = nd - a; }
                    else { a += c0; if (a + c1 >= nd) { dg = 254 - 4 * lane; nn = nd - a; }
                        else { a += c1; if (a + c2 >= nd) { dg = 253 - 4 * lane; nn = nd - a; } else { a += c2; dg = 252 - 4 * lane; nn = nd - a; } } }
                    prefix[row] = (prefix[row] << 8) | (unsigned)dg; need[row] = nn;
                }
            }
            __syncthreads();
        }
    }
    __syncthreads();
}

__device__ __forceinline__ void wave_find(unsigned c, unsigned need, int lane, int& sl, unsigned& excl_at) {
    unsigned incl = c;
#pragma unroll
    for (int o = 1; o < 64; o <<= 1) { const unsigned t = __shfl_up(incl, o); if (lane >= o) incl += t; }
    const unsigned excl = incl - c;
    const unsigned long long b = __builtin_amdgcn_ballot_w64(excl < need && need <= incl);
    sl = b ? (int)__builtin_ctzll(b) : 63;
    excl_at = __shfl(excl, sl);
}
__device__ __forceinline__ void idx_scores(const bf16x8 ikf, const bf16x8 (&iq)[2][8], const float (&iw)[2][8], const bf16x8 (&iql)[2][2], float (&sc)[2][4]) {
#pragma unroll
    for (int qt = 0; qt < 2; ++qt) {
        f32x4 L = (f32x4){0.f, 0.f, 0.f, 0.f};
        L = __builtin_amdgcn_mfma_f32_16x16x32_bf16(ikf, iql[qt][0], L, 0, 0, 0);
        L = __builtin_amdgcn_mfma_f32_16x16x32_bf16(ikf, iql[qt][1], L, 0, 0, 0);
#pragma unroll
        for (int j = 0; j < 4; ++j) sc[qt][j] = L[j];
#pragma unroll
        for (int h = 0; h < 8; ++h) {
            f32x4 a = (f32x4){0.f, 0.f, 0.f, 0.f};
            a = __builtin_amdgcn_mfma_f32_16x16x32_bf16(ikf, iq[qt][h], a, 0, 0, 0);
#pragma unroll
            for (int j = 0; j < 4; ++j) sc[qt][j] = __builtin_fmaf(iw[qt][h], __builtin_fabsf(a[j]), sc[qt][j]);
        }
    }
}
__device__ __forceinline__ unsigned mono_key(float s) { const unsigned u = __float_as_uint(s + 0.0f); return u ^ ((unsigned)((int)u >> 31) | 0x80000000u); }
__device__ __forceinline__ float key_edge(unsigned kk) { return __uint_as_float((kk & 0x80000000u) ? (kk ^ 0x80000000u) : ~kk); }
constexpr int ICAP = 512;
__device__ __forceinline__ bool indexer_fast(LAS unsigned char* lds, const bf16_t* H, unsigned char* MASKB, int bl, int qb) {
    LAS unsigned* H11 = (LAS unsigned*)lds;
    LAS unsigned* KL = (LAS unsigned*)lds;
    LAS unsigned short* IL = (LAS unsigned short*)(lds + 65536);
    LAS unsigned char* LM = lds + 98304;
    LAS int* tbin = (LAS int*)(lds + LDS_MISC + 128);
    LAS unsigned* need1 = (LAS unsigned*)(lds + LDS_MISC + 256);
    LAS unsigned* cc = (LAS unsigned*)(lds + LDS_MISC + 384);
    LAS unsigned* ovf = (LAS unsigned*)(lds + LDS_MISC + 512);
    LAS unsigned* hist2 = (LAS unsigned*)(lds + LDS_MISC + 1024);
    const int tid = otid(), wid = __builtin_amdgcn_readfirstlane(tid >> 6), lane = tid & 63, lr = lane & 15, lg = lane >> 4;
    const int q0 = qb * 32; const size_t rowbase = (size_t)bl * SEQ;
    const int nks = (q0 + 31) / 128 + 1;
    __syncthreads();
    for (int i = tid; i < 32 * 1025 / 4; i += NTHREADS) ((LAS u32x4*)H11)[i] = (u32x4){0u, 0u, 0u, 0u};
    if (tid < 32) cc[tid] = 0u;
    if (tid == 0) *ovf = 0u;
    bf16x8 iq[2][8]; float iw[2][8];
#pragma unroll
    for (int qt = 0; qt < 2; ++qt) {
        const bf16_t* hr = H + (rowbase + q0 + qt * 16 + lr) * NP1;
#pragma unroll
        for (int h = 0; h < 8; ++h) iq[qt][h] = *(const bf16x8*)(hr + AIQ + h * 32 + lg * 8);
        const u32x4 w = *(const u32x4*)(hr + AIW); float f[8]; unpack8(w, f);
#pragma unroll
        for (int h = 0; h < 8; ++h) iw[qt][h] = f[h];
    }
    bf16x8 iql[2][2];
#pragma unroll
    for (int qt = 0; qt < 2; ++qt) {
        float qa[8];
#pragma unroll
        for (int i = 0; i < 8; ++i) qa[i] = 0.f;
#pragma unroll
        for (int h = 0; h < 8; ++h) { float qf8[8]; unpack8(__builtin_bit_cast(u32x4, iq[qt][h]), qf8);
#pragma unroll
            for (int i = 0; i < 8; ++i) qa[i] += iw[qt][h] * qf8[i]; }
        float qh[8], ql[8];
#pragma unroll
        for (int i = 0; i < 8; ++i) { qh[i] = bf2f(f2bf(qa[i])); ql[i] = qa[i] - qh[i]; }
        iql[qt][0] = __builtin_bit_cast(bf16x8, pack8(qh)); iql[qt][1] = __builtin_bit_cast(bf16x8, pack8(ql));
    }
    const int tq0 = q0 + lr, tq1 = q0 + 16 + lr;
    __syncthreads();
    const bf16_t* ikp = H + (rowbase + wid * 16 + lr) * NP1 + AIK + lg * 8;
    bf16x8 ikn0 = *(const bf16x8*)ikp, ikn1 = *(const bf16x8*)(ikp + (size_t)(nks > 1 ? 1 : 0) * 128 * NP1);
    for (int ks = 0; ks < nks; ++ks) {
        const int kb = ks * 128 + wid * 16;
        const bf16x8 ikf = ikn0; ikn0 = ikn1;
        { const int kn = (ks + 2 < nks) ? ks + 2 : nks - 1; ikn1 = *(const bf16x8*)(ikp + (size_t)kn * 128 * NP1); }
        float sc[2][4]; idx_scores(ikf, iq, iw, iql, sc);
        const bool chk = (ks == nks - 1);
#pragma unroll
        for (int qt = 0; qt < 2; ++qt) {
            const int tq = qt ? tq1 : tq0;
#pragma unroll
            for (int j = 0; j < 4; ++j) {
                const int key = kb + lg * 4 + j;
                const unsigned bin = mono_key(sc[qt][j]) >> 21;
                unsigned inc = (bin & 1u) ? 65536u : 1u;
                if (chk) inc = (key <= tq) ? inc : 0u;
                __hip_atomic_fetch_add(&H11[(qt * 16 + lr) * 1025 + (bin >> 1)], inc, __ATOMIC_RELAXED, __HIP_MEMORY_SCOPE_WORKGROUP);
            }
        }
    }
#ifdef DUP_IDX_P0
    { ikn0 = *(const bf16x8*)ikp; ikn1 = ikn0;
      for (int ks = 0; ks < nks; ++ks) {
        const bf16x8 ikf = ikn0; ikn0 = ikn1;
        { const int kn = (ks + 2 < nks) ? ks + 2 : nks - 1; ikn1 = *(const bf16x8*)(ikp + (size_t)kn * 128 * NP1); }
        float sc[2][4]; idx_scores(ikf, iq, iw, iql, sc);
#pragma unroll
        for (int qt = 0; qt < 2; ++qt)
#pragma unroll
            for (int j = 0; j < 4; ++j) { const unsigned bin = mono_key(sc[qt][j]) >> 21; unsigned inc = (bin == 5000u) ? 1u : 0u;
                __hip_atomic_fetch_add(&H11[(qt * 16 + lr) * 1025 + (bin >> 1)], inc, __ATOMIC_RELAXED, __HIP_MEMORY_SCOPE_WORKGROUP); }
      } }
#endif
#ifdef DUP_IDX_SC
    { float dsum = 0.f;
      ikn0 = *(const bf16x8*)ikp; ikn1 = ikn0;
      for (int ks = 0; ks < nks; ++ks) {
        const bf16x8 ikf = ikn0; ikn0 = ikn1;
        { const int kn = (ks + 2 < nks) ? ks + 2 : nks - 1; ikn1 = *(const bf16x8*)(ikp + (size_t)kn * 128 * NP1); }
        float sc[2][4]; idx_scores(ikf, iq, iw, iql, sc);
#pragma unroll
        for (int qt = 0; qt < 2; ++qt)
#pragma unroll
            for (int j = 0; j < 4; ++j) dsum += sc[qt][j];
      }
      if (dsum == 12345.678f) MASKB[0] = 1; }
#endif
    __syncthreads();
    for (int r = 0; r < 4; ++r) {
        const int row = wid * 4 + r;
        if (q0 + row < 256) { if (lane == 0) { tbin[row] = -1; need1[row] = 0u; } continue; }
        const LAS unsigned* hp = H11 + row * 1025 + 1008 - 16 * lane;
        unsigned c = 0u;
#pragma unroll
        for (int i = 0; i < 16; ++i) { const unsigned w = hp[i]; c += (w & 0xffffu) + (w >> 16); }
        int L1; unsigned ex1; wave_find(c, 256u, lane, L1, ex1);
        const int top = 2047 - 32 * L1; const unsigned need2 = 256u - ex1;
        unsigned c2 = 0u;
        if (lane < 32) { const int bin = top - lane; const unsigned w = H11[row * 1025 + (bin >> 1)]; c2 = (bin & 1) ? (w >> 16) : (w & 0xffffu); }
        int L2; unsigned ex2; wave_find(c2, need2, lane, L2, ex2);
        if (lane == 0) { tbin[row] = top - L2; need1[row] = need2 - ex2; }
    }
    __syncthreads();
    {
        const int tb0 = tbin[lr], tb1 = tbin[16 + lr];
        const float lo0 = tb0 < 0 ? -INFINITY : key_edge((unsigned)tb0 << 21), hi0 = tb0 < 0 ? -INFINITY : (tb0 >= 2047 ? INFINITY : key_edge(((unsigned)tb0 + 1u) << 21));
        const float lo1 = tb1 < 0 ? -INFINITY : key_edge((unsigned)tb1 << 21), hi1 = tb1 < 0 ? -INFINITY : (tb1 >= 2047 ? INFINITY : key_edge(((unsigned)tb1 + 1u) << 21));
        ikn0 = *(const bf16x8*)ikp; ikn1 = *(const bf16x8*)(ikp + (size_t)(nks > 1 ? 1 : 0) * 128 * NP1);
        for (int ks = 0; ks < nks; ++ks) {
            const int kb = ks * 128 + wid * 16;
            const bf16x8 ikf = ikn0; ikn0 = ikn1;
            { const int kn = (ks + 2 < nks) ? ks + 2 : nks - 1; ikn1 = *(const bf16x8*)(ikp + (size_t)kn * 128 * NP1); }
            float sc[2][4]; idx_scores(ikf, iq, iw, iql, sc);
            const bool chk = (ks == nks - 1);
#pragma unroll
            for (int qt = 0; qt < 2; ++qt) {
                const int tq = qt ? tq1 : tq0; const float loe = qt ? lo1 : lo0, hie = qt ? hi1 : hi0; const int q = qt * 16 + lr;
                unsigned b = 0u;
#pragma unroll
                for (int j = 0; j < 4; ++j) {
                    const int key = kb + lg * 4 + j;
                    const float sv = sc[qt][j];
                    const bool causal = !chk || (key <= tq);
                    const bool above = sv >= hie;
                    b |= (causal && above) ? (1u << (lg * 4 + j)) : 0u;
                    if (causal && !above && sv >= loe) {
                        const unsigned slot = __hip_atomic_fetch_add(&cc[q], 1u, __ATOMIC_RELAXED, __HIP_MEMORY_SCOPE_WORKGROUP);
                        if (slot < (unsigned)ICAP) { KL[q * ICAP + slot] = mono_key(sv); IL[q * ICAP + slot] = (unsigned short)key; }
                    }
                }
                b |= __shfl_xor(b, 16); b |= __shfl_xor(b, 32);
                if (lg == 0) *(LAS unsigned short*)(LM + q * 1024 + (ks * 8 + wid) * 2) = (unsigned short)b;
            }
        }
    }
    __syncthreads();
    if (tid < 32 && cc[tid] > (unsigned)ICAP) *ovf = 1u;
    __syncthreads();
    if (*ovf != 0u) return false;
    for (int r = 0; r < 4; ++r) {
        const int row = wid * 4 + r; const int n = (int)cc[row]; const int tb = tbin[row];
        if (tb < 0 || n == 0) continue;
        unsigned need = need1[row], pfx = 0u, cnt_eq = 0u;
        LAS unsigned* hh = hist2 + wid * 128;
#pragma unroll 1
        for (int rp = 0; rp < 3; ++rp) {
            const int shift = 14 - 7 * rp;
            hh[lane] = 0u; hh[64 + lane] = 0u;
            __builtin_amdgcn_wave_barrier();
            for (int e = lane; e < n; e += 64) {
                const unsigned k = KL[row * ICAP + e] & 0x1fffffu;
                if (rp == 0 || (k >> (shift + 7)) == pfx) __hip_atomic_fetch_add(&hh[(k >> shift) & 127u], 1u, __ATOMIC_RELAXED, __HIP_MEMORY_SCOPE_WORKGROUP);
            }
            __builtin_amdgcn_wave_barrier();
            const unsigned c_hi = hh[127 - 2 * lane], c_lo = hh[126 - 2 * lane];
            __builtin_amdgcn_wave_barrier();
            int L; unsigned ex; wave_find(c_hi + c_lo, need, lane, L, ex);
            const unsigned chiL = __shfl(c_hi, L), cloL = __shfl(c_lo, L);
            unsigned rem = need - ex; unsigned digit;
            if (rem <= chiL) { digit = 127u - 2u * (unsigned)L; cnt_eq = chiL; } else { digit = 126u - 2u * (unsigned)L; rem -= chiL; cnt_eq = cloL; }
            pfx = (pfx << 7) | digit; need = rem;
        }
        for (int e = lane; e < n; e += 64) {
            const unsigned k = KL[row * ICAP + e] & 0x1fffffu; const unsigned idx = IL[row * ICAP + e];
            bool sel = k > pfx;
            if (k == pfx) {
                if (cnt_eq <= need) sel = true;
                else { unsigned rank = 0u; for (int e2 = 0; e2 < n; ++e2) { const unsigned k2 = KL[row * ICAP + e2] & 0x1fffffu; const unsigned i2 = IL[row * ICAP + e2]; rank += (k2 == pfx && i2 < idx) ? 1u : 0u; } sel = rank < need; }
            }
            if (sel) __hip_atomic_fetch_or((LAS unsigned*)(LM + row * 1024) + (idx >> 5), 1u << (idx & 31u), __ATOMIC_RELAXED, __HIP_MEMORY_SCOPE_WORKGROUP);
        }
    }
    __syncthreads();
    for (int c = tid; c < 32 * nks; c += NTHREADS) { const int row = c / nks, ch = c % nks; *(u32x4*)(MASKB + (rowbase + q0 + row) * 1024 + ch * 16) = *(const LAS u32x4*)(LM + row * 1024 + ch * 16); }
    __syncthreads();
    return true;
}

struct AttnArgs {
    const bf16_t* q; long q_rs; const bf16_t* k; long k_rs; const bf16_t* v; long v_rs;
    int i0; int maxdist; float bound; float l_init;
    const unsigned long long* mask;
    bf16_t* o; long o_rs; const bf16_t* z; long z_rs; float* md; long md_rs;
};
template <int DQK, int VAR>
__device__ __forceinline__ void attn_tile(const LAS bf16_t* sK, const LAS bf16_t* sVt, const LAS float* sBias, const bf16x8 (&qf)[2][DQK / 32], f32x4 (&o)[2][4], float (&lsum)[2],
                                          int qi, int key0, int maxdist, const unsigned (&mlo)[2], const unsigned (&mhi)[2], float sinit, int lr, int lg) {
    constexpr int KP = DQK + 8, VP = 72;
    f32x4 s[2][4];
    u32x4 vfr[2][4];
#pragma unroll
    for (int ch = 0; ch < 2; ++ch) {
        bf16x8 kfr[2][DQK / 32];
#pragma unroll
        for (int c = 0; c < 2; ++c)
#pragma unroll
            for (int ks = 0; ks < DQK / 32; ++ks) kfr[c][ks] = *(const LAS bf16x8*)(sK + ((ch * 2 + c) * 16 + lr) * KP + ks * 32 + lg * 8);
        __builtin_amdgcn_sched_barrier(0);
        __builtin_amdgcn_s_setprio(1);
#pragma unroll
        for (int c = 0; c < 2; ++c) {
            s[0][ch * 2 + c] = (f32x4){sinit, sinit, sinit, sinit}; s[1][ch * 2 + c] = s[0][ch * 2 + c];
#pragma unroll
            for (int ks = 0; ks < DQK / 32; ++ks) {
                s[0][ch * 2 + c] = __builtin_amdgcn_mfma_f32_16x16x32_bf16(kfr[c][ks], qf[0][ks], s[0][ch * 2 + c], 0, 0, 0);
                s[1][ch * 2 + c] = __builtin_amdgcn_mfma_f32_16x16x32_bf16(kfr[c][ks], qf[1][ks], s[1][ch * 2 + c], 0, 0, 0);
            }
        }
        __builtin_amdgcn_s_setprio(0);
        __builtin_amdgcn_sched_barrier(0);
    }
    __builtin_amdgcn_s_setprio(0);
    __builtin_amdgcn_sched_barrier(0);
#pragma unroll
    for (int kk = 0; kk < 2; ++kk)
#pragma unroll
        for (int dt = 0; dt < 4; ++dt) {
            const LAS bf16_t* vp = sVt + (dt * 16 + lr) * VP + kk * 32 + lg * 4;
            const u32x2 v0 = *(const LAS u32x2*)vp, v1 = *(const LAS u32x2*)(vp + 16);
            vfr[kk][dt].x = v0.x; vfr[kk][dt].y = v0.y; vfr[kk][dt].z = v1.x; vfr[kk][dt].w = v1.y;
        }
    __builtin_amdgcn_sched_barrier(0);
#pragma unroll
    for (int qt = 0; qt < 2; ++qt) {
        const int dq = qi + qt * 16 - key0 - lg * 4;
        const LAS float* bp = sBias + (dq + 33);
        float ps = 0.f;
#pragma unroll
        for (int c = 0; c < 4; ++c)
#pragma unroll
            for (int j = 0; j < 4; ++j) {
                float val = s[qt][c][j]; float pv;
                if (VAR == 0) pv = fexp2(val);
                else if (VAR == 1) { pv = fexp2(val); pv = (dq >= c * 16 + j) ? pv : 0.f; }
                else if (VAR == 2) { pv = fexp2(val + bp[63 - (c * 16 + j)]); }
                else if (VAR == 3) { pv = fexp2(val); pv = __uint_as_float(__float_as_uint(pv) & (unsigned)__builtin_amdgcn_sbfe((int)(c < 2 ? mlo[qt] : mhi[qt]), (c & 1) * 16 + j, 1)); }
                else { pv = fexp2(val + bp[63 - (c * 16 + j)]); pv = __uint_as_float(__float_as_uint(pv) & (unsigned)__builtin_amdgcn_sbfe((int)(c < 2 ? mlo[qt] : mhi[qt]), (c & 1) * 16 + j, 1)); }
                s[qt][c][j] = pv; ps += pv;
            }
        lsum[qt] += ps;
    }
    __builtin_amdgcn_s_setprio(1);
#pragma unroll
    for (int kk = 0; kk < 2; ++kk) {
        bf16x8 pb[2];
#pragma unroll
        for (int qt = 0; qt < 2; ++qt) {
            u32x4 pw; pw.x = pk2(s[qt][2 * kk][0], s[qt][2 * kk][1]); pw.y = pk2(s[qt][2 * kk][2], s[qt][2 * kk][3]); pw.z = pk2(s[qt][2 * kk + 1][0], s[qt][2 * kk + 1][1]); pw.w = pk2(s[qt][2 * kk + 1][2], s[qt][2 * kk + 1][3]);
            pb[qt] = __builtin_bit_cast(bf16x8, pw);
        }
#pragma unroll
        for (int dt = 0; dt < 4; ++dt) {
            const bf16x8 vf = __builtin_bit_cast(bf16x8, vfr[kk][dt]);
            o[0][dt] = __builtin_amdgcn_mfma_f32_16x16x32_bf16(vf, pb[0], o[0][dt], 0, 0, 0);
            o[1][dt] = __builtin_amdgcn_mfma_f32_16x16x32_bf16(vf, pb[1], o[1][dt], 0, 0, 0);
        }
    }
    __builtin_amdgcn_s_setprio(0);
}
template <int DQK, int MODE>
__device__ __forceinline__ void attn_unit(LAS unsigned char* lds, const AttnArgs& a, const unsigned char* lut) {
    constexpr int KP = DQK + 8, VP = 72, KCH = DQK / 8;
    const LAS float* sBias = (const LAS float*)(lds + 49152);
    LAS unsigned char* sUni = (LAS unsigned char*)(lds + 83968);
    const int tid = otid(), wid = __builtin_amdgcn_readfirstlane(tid >> 6), lane = tid & 63, lr = lane & 15, lg = lane >> 4;
    const int i0 = a.i0; const int qi = i0 + wid * 32 + lr;
    const int kt_hi = (i0 + 255) >> 6;
    int kt_lo = 0;
    if (MODE == 1) { const int lo = i0 - a.maxdist; kt_lo = lo > 0 ? (lo >> 6) : 0; }
    const int wq_min = i0 + wid * 32, wq_max = wq_min + 31;
    if (MODE == 2) {
        for (int e = tid; e < 8 * (kt_hi + 1); e += NTHREADS) {
            const int w = e / (kt_hi + 1), kt = e % (kt_hi + 1);
            const int dmin = i0 + w * 32 - (kt * 64 + 63), dmax = i0 + w * 32 + 31 - kt * 64;
            sUni[w * 132 + kt] = (dmin >= 0 && lut[dmin] == lut[dmax]) ? 1 : 0;
        }
    }
    bf16x8 qf[2][DQK / 32];
#pragma unroll
    for (int qt = 0; qt < 2; ++qt)
#pragma unroll
        for (int ks = 0; ks < DQK / 32; ++ks) qf[qt][ks] = *(const bf16x8*)(a.q + (long)(qi + qt * 16) * a.q_rs + ks * 32 + lg * 8);
    float lsum[2]; lsum[0] = (lg == 0) ? a.l_init : 0.f; lsum[1] = lsum[0];
    const float nb = -a.bound;
    f32x4 o[2][4];
#pragma unroll
    for (int qt = 0; qt < 2; ++qt)
#pragma unroll
        for (int d = 0; d < 4; ++d) o[qt][d] = (f32x4){0.f, 0.f, 0.f, 0.f};
    u32x4 rk0, rk1; u32x2 rv0, rv1;
    const int kkey0 = tid / KCH, kpart0 = tid % KCH; const int kkey1 = (tid + 512) / KCH, kpart1 = (tid + 512) % KCH;
    const int vkp = tid & 31, vdg = tid >> 5;
#define ATT_LOAD(kt) do { const long kb_ = (long)(kt) * 64; \
        rk0 = *(const u32x4*)(a.k + (kb_ + kkey0) * a.k_rs + kpart0 * 8); \
        if (DQK == 96 && tid < 256) rk1 = *(const u32x4*)(a.k + (kb_ + kkey1) * a.k_rs + kpart1 * 8); \
        rv0 = *(const u32x2*)(a.v + (kb_ + 2 * vkp) * a.v_rs + vdg * 4); rv1 = *(const u32x2*)(a.v + (kb_ + 2 * vkp + 1) * a.v_rs + vdg * 4); } while (0)
#define ATT_STORE(buf) do { LAS bf16_t* sK_ = (LAS bf16_t*)(lds + (buf) * 24576); LAS bf16_t* sV_ = (LAS bf16_t*)(lds + (buf) * 24576 + 14336); \
        *(LAS u32x4*)(sK_ + kkey0 * KP + kpart0 * 8) = rk0; \
        if (DQK == 96 && tid < 256) *(LAS u32x4*)(sK_ + kkey1 * KP + kpart1 * 8) = rk1; \
        *(LAS unsigned*)(sV_ + (vdg * 4 + 0) * VP + 2 * vkp) = (rv0.x & 0xffffu) | (rv1.x << 16); \
        *(LAS unsigned*)(sV_ + (vdg * 4 + 1) * VP + 2 * vkp) = (rv0.x >> 16) | (rv1.x & 0xffff0000u); \
        *(LAS unsigned*)(sV_ + (vdg * 4 + 2) * VP + 2 * vkp) = (rv0.y & 0xffffu) | (rv1.y << 16); \
        *(LAS unsigned*)(sV_ + (vdg * 4 + 3) * VP + 2 * vkp) = (rv0.y >> 16) | (rv1.y & 0xffff0000u); } while (0)
    ATT_LOAD(kt_lo);
    ATT_STORE(0);
    if (kt_lo < kt_hi) ATT_LOAD(kt_lo + 1);
    unsigned long long mwn0 = 0ull, mwn1 = 0ull;
    if (MODE == 2) { mwn0 = a.mask[(long)qi * 128 + kt_lo]; mwn1 = a.mask[(long)(qi + 16) * 128 + kt_lo]; }
    __syncthreads();
    for (int kt = kt_lo; kt <= kt_hi; ++kt) {
        const int cur = (kt - kt_lo) & 1;
        if (kt < kt_hi) ATT_STORE(cur ^ 1);
        if (kt + 1 < kt_hi) ATT_LOAD(kt + 2);
        const unsigned long long mwc0 = mwn0, mwc1 = mwn1;
        if (MODE == 2 && kt < kt_hi) { mwn0 = a.mask[(long)qi * 128 + kt + 1]; mwn1 = a.mask[(long)(qi + 16) * 128 + kt + 1]; }
        const LAS bf16_t* sK = (const LAS bf16_t*)(lds + cur * 24576); const LAS bf16_t* sVt = (const LAS bf16_t*)(lds + cur * 24576 + 14336);
        const int key0 = kt * 64;
        bool skip = key0 > wq_max;
        if (MODE == 1) skip = skip || (key0 + 63 < wq_min - a.maxdist);
        if (!skip) {
            unsigned mlo[2] = {0u, 0u}, mhi[2] = {0u, 0u};
            if (MODE == 0) {
                if (key0 + 63 <= wq_min) attn_tile<DQK, 0>(sK, sVt, sBias, qf, o, lsum, qi, key0, 0, mlo, mhi, nb, lr, lg);
                else attn_tile<DQK, 1>(sK, sVt, sBias, qf, o, lsum, qi, key0, 0, mlo, mhi, nb, lr, lg);
            } else if (MODE == 1) {
                attn_tile<DQK, 2>(sK, sVt, sBias, qf, o, lsum, qi, key0, a.maxdist, mlo, mhi, nb, lr, lg);
            } else {
                const unsigned long long w0 = mwc0 >> (lg * 4), w1 = mwc1 >> (lg * 4);
                mlo[0] = (unsigned)w0; mhi[0] = (unsigned)(w0 >> 32); mlo[1] = (unsigned)w1; mhi[1] = (unsigned)(w1 >> 32);
                const int uni = __builtin_amdgcn_readfirstlane((int)sUni[wid * 132 + kt]);
                if (uni) { const float ub = sBias[96 + wq_min - key0]; attn_tile<DQK, 3>(sK, sVt, sBias, qf, o, lsum, qi, key0, 0, mlo, mhi, nb + ub, lr, lg); }
                else attn_tile<DQK, 4>(sK, sVt, sBias, qf, o, lsum, qi, key0, 0, mlo, mhi, nb, lr, lg);
            }
        }
        __syncthreads();
    }
#undef ATT_LOAD
#undef ATT_STORE
#pragma unroll
    for (int qt = 0; qt < 2; ++qt) {
        const int qr = qi + qt * 16;
        float lt = lsum[qt]; lt += __shfl_xor(lt, 16); lt += __shfl_xor(lt, 32);
        const float inv = 1.0f / lt;
        u32x2 zw[4];
#pragma unroll
        for (int dt = 0; dt < 4; ++dt) zw[dt] = (u32x2){0x3f803f80u, 0x3f803f80u};
        if (a.z) {
#pragma unroll
            for (int dt = 0; dt < 4; ++dt) zw[dt] = *(const u32x2*)(a.z + (long)qr * a.z_rs + dt * 16 + lg * 4);
        }
#pragma unroll
        for (int dt = 0; dt < 4; ++dt) {
            float r[4];
#pragma unroll
            for (int j = 0; j < 4; ++j) r[j] = o[qt][dt][j] * inv;
            const int col = dt * 16 + lg * 4;
            if (a.z) {
                r[0] *= silu_f(__uint_as_float(zw[dt].x << 16)); r[1] *= silu_f(__uint_as_float(zw[dt].x & 0xffff0000u));
                r[2] *= silu_f(__uint_as_float(zw[dt].y << 16)); r[3] *= silu_f(__uint_as_float(zw[dt].y & 0xffff0000u)); }
            u32x2 w; w.x = pk2(r[0], r[1]); w.y = pk2(r[2], r[3]);
            *(u32x2*)(a.o + (long)qr * a.o_rs + col) = w;
        }
        if (a.md && lg == 0) { a.md[(long)qr * a.md_rs] = a.bound; a.md[(long)qr * a.md_rs + 1] = lt; }
    }
}

__device__ __forceinline__ float logit_bound(const float* gq, const float* gk, int dim, const float* bias_col, float extra) {
    const int lane = otid() & 63;
    float a = 0.f, b = 0.f, c = 0.f;
    for (int i = lane; i < dim; i += 64) { a = fmaxf(a, fabsf(gq[i])); b = fmaxf(b, fabsf(gk[i])); }
    if (bias_col && lane < 32) c = fabsf(bias_col[lane * NBH]);
#pragma unroll
    for (int o = 1; o < 64; o <<= 1) { a = fmaxf(a, __shfl_xor(a, o)); b = fmaxf(b, __shfl_xor(b, o)); c = fmaxf(c, __shfl_xor(c, o)); }
    return sqrtf((float)dim) * a * b * LOG2E * 1.03f + c * LOG2E + 0.25f + extra;
}

__device__ __forceinline__ void bcombine_phase(const bf16_t* H, const float* MD, bf16_t* YZ, int Tc) {
    const int lane = otid() & 63; const int gw = (obid() * NTHREADS + otid()) >> 6, nw = (gridDim.x * NTHREADS) >> 6;
    const int h = lane >> 3, d0 = (lane & 7) * 8;
    for (int row = gw; row < Tc; row += nw) {
        float mm[3], dd[3];
#pragma unroll
        for (int g = 0; g < 3; ++g) { mm[g] = MD[((size_t)row * 24 + g * 8 + h) * 2]; dd[g] = MD[((size_t)row * 24 + g * 8 + h) * 2 + 1]; }
        const float M = fmaxf(mm[0], fmaxf(mm[1], mm[2]));
        float w[3]; float ws = 0.f;
#pragma unroll
        for (int g = 0; g < 3; ++g) { w[g] = dd[g] * fexp2(mm[g] - M); ws += w[g]; }
        const float inv = 1.0f / ws;
        float acc[8];
#pragma unroll
        for (int i = 0; i < 8; ++i) acc[i] = 0.f;
#pragma unroll
        for (int g = 0; g < 3; ++g) { const u32x4 ow = *(const u32x4*)(H + (size_t)row * NP1 + BQ + g * 512 + h * 64 + d0); float f[8]; unpack8(ow, f);
#pragma unroll
            for (int i = 0; i < 8; ++i) acc[i] += w[g] * inv * f[i]; }
        const u32x4 zw = *(const u32x4*)(H + (size_t)row * NP1 + BZ + h * 64 + d0); float zf[8]; unpack8(zw, zf);
#pragma unroll
        for (int i = 0; i < 8; ++i) acc[i] *= silu_f(zf[i]);
        *(u32x4*)(YZ + (size_t)row * 2048 + 512 + h * 64 + d0) = pack8(acc);
    }
}

__global__ void __launch_bounds__(NTHREADS) mega_fwd(Params p) {
    extern __shared__ __attribute__((aligned(16))) unsigned char lds_raw[];
    LAS unsigned char* lds = (LAS unsigned char*)lds_raw;
    cg::grid_group grid = cg::this_grid();
    const int nbc = p.nbc, Tc = nbc * SEQ, nchunk = NBATCH / nbc;
    const int G = gridDim.x, bx = obid(), tid = otid();

    { LAS unsigned* misc = (LAS unsigned*)(lds + LDS_MISC); if (tid < 16) misc[tid] = 0u; }
    __syncthreads();
    XcdBarrier xb = xcd_barrier_post((unsigned*)(p.ws + 4096), (volatile LAS unsigned*)(lds + LDS_MISC + 32));
    { const WsMap wm = make_map(nbc); setup_phase(p, wm, lds); }
    grid.sync();

#pragma unroll 1
    for (int l = 0; l < DEPTH; ++l) {
        const float* xin = (l == 0) ? p.x : p.out;
        { const WsMap wm = make_map(nbc); p0_phase(xin, p.norm_gain + l * DM, (bf16_t*)(p.ws + wm.xb)); }
        xcd_barrier(xb);
#pragma unroll 1
        for (int ch = 0; ch < nchunk; ++ch) {
#pragma unroll 1
            for (int ph = 0; ph < 13; ++ph) {
                const WsMap wm = make_map(nbc);
                bf16_t* XB = (bf16_t*)(p.ws + wm.xb); bf16_t* H = (bf16_t*)(p.ws + wm.h);
                bf16_t* QC = (bf16_t*)(p.ws + wm.qc); bf16_t* KC = (bf16_t*)(p.ws + wm.kc); bf16_t* KV = (bf16_t*)(p.ws + wm.kv);
                unsigned long long* MASK = (unsigned long long*)(p.ws + wm.mask); float* MD = (float*)(p.ws + wm.md);
                bf16_t* YZ = (bf16_t*)(p.ws + wm.yz); float* MG = (float*)(p.ws + wm.mg); bf16_t* MGb = (bf16_t*)(p.ws + wm.mgb);
                const unsigned char* lut = p.ws + wm.lut;
                const float* biasd = (const float*)(p.ws + wm.biasd); const float* bnd = (const float*)(p.ws + wm.bnd);
                int* ctl = (int*)(p.ws + wm.ctl);
                const size_t tok0 = (size_t)ch * Tc;
                bool do_sync = true;
                if (ph == 0) {
                    pg8::Gemm g{XB + tok0 * DM, (const bf16_t*)(p.ws + wm.winT) + (size_t)l * NP1 * DM, Tc, NP1, DM, DM, 0, 0};
                    pg8::EpiStoreNorm E{H, p.qga + l * 128, p.qgb + l * 128, p.qgd + l * 128, (LAS float*)(lds + LDS_MISC + 6144)};
                    pg8::StaticOrder S; S.init(g.M, g.N, G, bx);
#ifndef SK_GS
                    pg8::gemm_phase(lds, g, S, E);
#endif
                } else if (ph == 2 || ph == 3 || ph == 7) {
                    pg8::Gemm g; pg8::EpiStore E;
                    if (ph == 2) { g = pg8::Gemm{H + CQ, (const bf16_t*)(p.ws + wm.wqbT) + (size_t)l * 768 * 256, Tc, 768, 256, NP1, 0, 0}; E = pg8::EpiStore{QC, 768, 0}; do_sync = false; }
                    else if (ph == 3) { g = pg8::Gemm{H + CKV, (const bf16_t*)(p.ws + wm.wkvbT) + (size_t)l * 1024 * 128, Tc, 1024, 128, NP1, 0, 0}; E = pg8::EpiStore{KV, 1024, 0}; }
                    else { g = pg8::Gemm{XB + tok0 * DM, (const bf16_t*)(p.ws + wm.wgT) + (size_t)l * 4096 * DM, Tc, 4096, DM, DM, 0, 0}; E = pg8::EpiStore{H + BQ, NP1, 1}; }
                    pg8::StaticOrder S; S.init(g.M, g.N, G, bx);
#ifndef SK_GS
                    pg8::gemm_phase(lds, g, S, E);
#endif
#ifdef DUP_GS
                    if (ph == 0) pg8::gemm_phase(lds, g, S, E);
#endif
#ifdef DUP_GG
                    if (ph == 7) pg8::gemm_phase(lds, g, S, E);
#endif
#ifdef DUP_GM
                    if (ph == 2 || ph == 3) pg8::gemm_phase(lds, g, S, E);
#endif
                } else if (ph == 1) {
                    norm_phase(p, H, Tc, l);
                } else if (ph == 4) {
                    mla_phase(p, wm, H, QC, KC, KV, Tc, l);
                } else if (ph == 5) {
                    int* ctr = ctl + (l * 4 + ch) * 2;
                    const int n_idx = nbc * 256, n_c = nbc * 8 * 32, n_b = 3 * nbc * 8 * 32, n_d = nbc * 8 * 32;
                    const int n_all = n_idx + n_c + n_b + n_d;
                    for (;;) {
                        int u = next_unit(ctr, lds);
                        if (u >= n_all) break;
                        if (u < n_idx) { const int qb = 255 - u / nbc, bl = u % nbc;
#ifndef SK_IDX
 if (!indexer_fast(lds, H, (unsigned char*)MASK, bl, qb)) indexer_unit(lds, H, (unsigned short*)MASK, bl, qb);
#endif
#ifdef DUP_IDX
 if (!indexer_fast(lds, H, (unsigned char*)MASK, bl, qb)) indexer_unit(lds, H, (unsigned short*)MASK, bl, qb);
#endif
 }
                        else if (u < n_idx + n_c) {
                            u -= n_idx;
                            const int blk = 31 - u / (nbc * 8), rem = u % (nbc * 8), bl = rem / 8, h = rem % 8;
                            AttnArgs a; const size_t r0 = (size_t)bl * SEQ;
                            a.q = QC + r0 * 768 + h * 96; a.q_rs = 768; a.k = KC + r0 * 768 + h * 96; a.k_rs = 768; a.v = KV + r0 * 1024 + h * 128 + 64; a.v_rs = 1024;
                            a.i0 = blk * 256; a.maxdist = 0; a.bound = bnd[l * 4 + 2]; a.l_init = 0.f; a.mask = nullptr;
                            a.o = YZ + r0 * 2048 + 1024 + h * 64; a.o_rs = 2048; a.z = H + r0 * NP1 + CZ + h * 64; a.z_rs = NP1; a.md = nullptr; a.md_rs = 0;
#ifndef SK_C
                            attn_unit<96, 0>(lds, a, lut);
#endif
#ifdef DUP_C
                            attn_unit<96, 0>(lds, a, lut);
#endif
                        } else {
                            u -= n_idx + n_c;
                            AttnArgs a; int dil, bcol;
                            if (u < n_b) {
                                const int g = u / (nbc * 8 * 32); int rem = u % (nbc * 8 * 32);
                                const int bl = rem / (8 * 32); rem %= (8 * 32); const int h = rem / 32; const int rb = rem % 32;
                                dil = (g == 0) ? 1 : (g == 1 ? 4 : 16); const int nblk = 32 / dil; const int r = rb / nblk, blk = rb % nblk;
                                bcol = 8 + g * 8 + h;
                                const size_t r0 = (size_t)bl * SEQ + r;
                                a.q = H + r0 * NP1 + BQ + g * 512 + h * 64; a.q_rs = (long)dil * NP1; a.k = H + r0 * NP1 + BKK + g * 512 + h * 64; a.k_rs = (long)dil * NP1;
                                a.v = H + r0 * NP1 + BV + g * 512 + h * 64; a.v_rs = (long)dil * NP1;
                                a.i0 = blk * 256; a.maxdist = 128; a.bound = bnd[l * 4 + 1]; a.l_init = 0.f; a.mask = nullptr;
                                a.o = H + r0 * NP1 + BQ + g * 512 + h * 64; a.o_rs = (long)dil * NP1; a.z = nullptr; a.z_rs = 0;
                                a.md = MD + (r0 * 24 + g * 8 + h) * 2; a.md_rs = (long)dil * 48;
                            } else {
                                u -= n_b;
                                const int bl = u / (8 * 32); const int rem = u % (8 * 32); const int h = rem / 32, blk = rem % 32;
                                dil = 1; bcol = 32 + h;
                                const size_t r0 = (size_t)bl * SEQ;
                                a.q = H + r0 * NP1 + DQ + h * 64; a.q_rs = NP1; a.k = H + r0 * NP1 + DK + (h >> 2) * 64; a.k_rs = NP1; a.v = H + r0 * NP1 + DV + (h >> 2) * 64; a.v_rs = NP1;
                                a.i0 = blk * 256; a.maxdist = 127; { const float sk = p.sinks[l * 8 + h] * LOG2E; a.bound = bnd[l * 4 + 3] + fmaxf(sk, 0.f); a.l_init = fexp2(sk - a.bound); } a.mask = nullptr;
                                a.o = YZ + r0 * 2048 + 1536 + h * 64; a.o_rs = 2048; a.z = H + r0 * NP1 + DZ + h * 64; a.z_rs = NP1; a.md = nullptr; a.md_rs = 0;
                            }
                            LAS float* sBias = (LAS float*)(lds + 49152); const int t2 = otid();
                            if (t2 < 96 + 129 + 96) { const int d = t2 - 96; sBias[t2] = (d < 0 || d > a.maxdist) ? -INFINITY : biasd[bcol * SEQ + d * dil]; }
#ifndef SK_B
                            attn_unit<64, 1>(lds, a, lut);
#endif
#ifdef DUP_D
                            if (a.md == nullptr) attn_unit<64, 1>(lds, a, lut);
#endif
                        }
                    }
                } else if (ph == 6) {
                    int* ctr = ctl + (l * 4 + ch) * 2 + 1;
                    const int n_a = nbc * 8 * 32;
                    for (;;) {
                        int u = next_unit(ctr, lds);
                        if (u >= n_a) break;
                        const int blk = 31 - u / (nbc * 8), rem = u % (nbc * 8), bl = rem / 8, h = rem % 8;
                        LAS float* sBias = (LAS float*)(lds + 49152); const int t2 = otid();
                        if (t2 < 96) sBias[t2] = 0.f;
                        for (int d = t2 * 4; d < blk * 256 + 256; d += NTHREADS * 4) *(LAS f32x4*)(sBias + 96 + d) = *(const f32x4*)(biasd + h * SEQ + d);
                        AttnArgs a; const size_t r0 = (size_t)bl * SEQ;
                        a.q = H + r0 * NP1 + AQ + h * 64; a.q_rs = NP1; a.k = H + r0 * NP1 + AK + h * 64; a.k_rs = NP1; a.v = H + r0 * NP1 + AV + h * 64; a.v_rs = NP1;
                        a.i0 = blk * 256; a.maxdist = 0; a.bound = bnd[l * 4 + 0]; a.l_init = 0.f; a.mask = MASK + r0 * 128;
                        a.o = YZ + r0 * 2048 + h * 64; a.o_rs = 2048; a.z = H + r0 * NP1 + AZ + h * 64; a.z_rs = NP1; a.md = nullptr; a.md_rs = 0;
#ifndef SK_A
                        attn_unit<64, 2>(lds, a, lut);
#endif
#ifdef DUP_A
                        attn_unit<64, 2>(lds, a, lut);
#endif
                    }
                    bcombine_phase(H, MD, YZ, Tc);
                } else if (ph < 12) {
                    if (ph == 8) {
                        pg8::Gemm g{YZ, (const bf16_t*)(p.ws + wm.wbrT) + (size_t)l * 4 * 1024 * 512, Tc, 1024, 512, 2048, (size_t)512 * 2, (size_t)1024 * 512 * 2};
                        pg8::BatchOrder4 S; S.base.init(Tc, 1024, G, bx);
                        pg8::EpiBranch E{MGb, H + BQ, NP1};
#ifndef SK_GB
                        pg8::gemm_phase(lds, g, S, E);
#endif
                    } else do_sync = false;
                } else {
                    pg8::Gemm g{MGb, (const bf16_t*)(p.ws + wm.woT) + (size_t)l * 1024 * 1024, Tc, 1024, 1024, 1024, 0, 0}; pg8::StaticOrder S; S.init(Tc, 1024, G, bx);
                    pg8::EpiOut E{xin + tok0 * DM, p.out + tok0 * DM};
#ifndef SK_GO
 pg8::gemm_phase(lds, g, S, E);
#endif
                }
                if (do_sync) xcd_barrier(xb);
#ifdef DUP_SYNC
                if (do_sync) xcd_barrier(xb);
#endif
            }
        }
    }
}

extern "C" void kernel_launch(void* const* d_in, const int* in_sizes, int n_in, void* d_out, int out_size, void* d_ws, size_t ws_size, hipStream_t stream) {
    static int grid_blocks = 0;
    if (!grid_blocks) {
        int dev = 0, cus = 0, per_cu = 0;
        hipGetDevice(&dev);
        hipDeviceGetAttribute(&cus, hipDeviceAttributeMultiprocessorCount, dev);
        hipFuncSetAttribute((const void*)mega_fwd, hipFuncAttributeMaxDynamicSharedMemorySize, LDS_BYTES);
        hipOccupancyMaxActiveBlocksPerMultiprocessor(&per_cu, (const void*)mega_fwd, NTHREADS, LDS_BYTES);
        if (per_cu < 1) per_cu = 1;
        if (per_cu > 1) per_cu = 1;
        grid_blocks = cus * per_cu;
    }
    Params p{};
    p.x = (const float*)d_in[0]; p.norm_gain = (const float*)d_in[1]; p.w_in = (const float*)d_in[2]; p.qga = (const float*)d_in[3]; p.qgb = (const float*)d_in[4];
    p.qgc = (const float*)d_in[5]; p.qgd = (const float*)d_in[6]; p.cq_gain = (const float*)d_in[7]; p.ckv_gain = (const float*)d_in[8]; p.w_q_b = (const float*)d_in[9];
    p.w_kv_b = (const float*)d_in[10]; p.sinks = (const float*)d_in[11]; p.rel_bias = (const float*)d_in[12]; p.w_branch = (const float*)d_in[13]; p.w_out = (const float*)d_in[14];
    p.out = (float*)d_out; p.ws = (unsigned char*)d_ws;
    p.nbc = (make_map(2).total <= ws_size) ? 2 : 1; p.pad = 0;
    hipMemsetAsync(d_ws, 0, 32768, stream);
    void* args[] = {&p};
    hipError_t e = hipLaunchCooperativeKernel((const void*)mega_fwd, dim3(grid_blocks), dim3(NTHREADS), args, LDS_BYTES, stream);
    if (e != hipSuccess) fprintf(stderr, "cooperative launch failed: %s (grid %d)\n", hipGetErrorString(e), grid_blocks);
}
```

```cpp
#include <hip/hip_runtime.h>
#include <hip/hip_cooperative_groups.h>
#include <cstdio>
#include <cstdint>
#include <cmath>
namespace cg = cooperative_groups;

#define LAS __attribute__((address_space(3)))
typedef unsigned short bf16_t;
typedef short bf16x8 __attribute__((ext_vector_type(8)));
typedef float f32x4 __attribute__((ext_vector_type(4)));
typedef unsigned u32x4 __attribute__((ext_vector_type(4)));
typedef unsigned u32x2 __attribute__((ext_vector_type(2)));

constexpr int DM = 1024, NBATCH = 4, SEQ = 8192, DEPTH = 4, TT = NBATCH * SEQ;
constexpr int NIN = 13768, NP1 = 9728, NHC = 9672;
constexpr int AQ = 0, AK = 512, AV = 1024, AZ = 1536, AIQ = 2048, AIK = 2304, AIW = 2336;
constexpr int BQ = 2368, BKK = 3904, BV = 5440, BZ = 6976;
constexpr int CKV = 7488, CPE = 7616, CQ = 7680, CZ = 7936;
constexpr int DQ = 8448, DK = 8960, DV = 9088, DZ = 9216;
constexpr int NBH = 40;
constexpr float LOG2E = 1.4426950408889634f;
constexpr int NTHREADS = 512;
constexpr int LDS_BYTES = 147456;
constexpr int LDS_MISC = 131072 + 256;

struct Params {
    const float* x; const float* norm_gain; const float* w_in; const float* qga; const float* qgb; const float* qgc; const float* qgd;
    const float* cq_gain; const float* ckv_gain; const float* w_q_b; const float* w_kv_b; const float* sinks; const float* rel_bias;
    const float* w_branch; const float* w_out;
    float* out; unsigned char* ws;
    int nbc; int pad;
};

struct WsMap { size_t biasd, bnd, ctl, winT, wgT, wbrT, woT, wqbT, wkvbT, lut, rope, xb, h, qc, kc, kv, mask, md, yz, mg, mgb, total; };
__host__ __device__ inline WsMap make_map(int nbc) {
    WsMap m; size_t o = 0; const size_t Tc = (size_t)nbc * SEQ;
    m.ctl = o; o += 32768;
    m.winT = o; o += (size_t)DEPTH * NP1 * DM * 2;
    m.wgT = o; o += (size_t)DEPTH * 4096 * DM * 2;
    m.wbrT = o; o += (size_t)DEPTH * 4 * 1024 * 512 * 2;
    m.woT = o; o += (size_t)DEPTH * 1024 * 1024 * 2;
    m.wqbT = o; o += (size_t)DEPTH * 768 * 256 * 2;
    m.wkvbT = o; o += (size_t)DEPTH * 1024 * 128 * 2;
    m.lut = o; o += 8192;
    m.biasd = o; o += (size_t)NBH * SEQ * 4;
    m.bnd = o; o += 256;
    m.rope = o; o += (size_t)SEQ * 32 * 4;
    m.xb = o; o += (size_t)TT * DM * 2;
    m.h = o; o += Tc * NP1 * 2;
    m.qc = o; o += Tc * 768 * 2;
    m.kc = o; o += Tc * 768 * 2;
    m.kv = o; o += Tc * 1024 * 2;
    m.mask = o; o += Tc * 1024;
    m.md = o; o += Tc * 48 * 4;
    m.yz = o; o += Tc * 2048 * 2;
    m.mg = o; o += Tc * 1024 * 4;
    m.mgb = o; o += Tc * 1024 * 2;
    m.total = o; return m;
}

__device__ __forceinline__ int otid() { int t = __builtin_amdgcn_workitem_id_x(); asm volatile("" : "+v"(t)); return t; }
__device__ __forceinline__ int obid() { int t = __builtin_amdgcn_workgroup_id_x(); asm volatile("" : "+s"(t)); return t; }
__device__ __forceinline__ float bf2f(unsigned h) { return __uint_as_float(h << 16); }
__device__ __forceinline__ unsigned f2bf(float f) { unsigned u = __float_as_uint(f); return (u + 0x7fffu + ((u >> 16) & 1u)) >> 16; }
typedef float f32x2_t __attribute__((ext_vector_type(2)));
typedef __bf16 bf16x2_t __attribute__((ext_vector_type(2)));
__device__ __forceinline__ unsigned pk2(float lo, float hi) { const f32x2_t v = {lo, hi}; return __builtin_bit_cast(unsigned, __builtin_convertvector(v, bf16x2_t)); }
__device__ __forceinline__ void unpack8(const u32x4 w, float (&f)[8]) {
    f[0] = __uint_as_float(w.x << 16); f[1] = __uint_as_float(w.x & 0xffff0000u);
    f[2] = __uint_as_float(w.y << 16); f[3] = __uint_as_float(w.y & 0xffff0000u);
    f[4] = __uint_as_float(w.z << 16); f[5] = __uint_as_float(w.z & 0xffff0000u);
    f[6] = __uint_as_float(w.w << 16); f[7] = __uint_as_float(w.w & 0xffff0000u);
}
__device__ __forceinline__ u32x4 pack8(const float (&f)[8]) { u32x4 w; w.x = pk2(f[0], f[1]); w.y = pk2(f[2], f[3]); w.z = pk2(f[4], f[5]); w.w = pk2(f[6], f[7]); return w; }
__device__ __forceinline__ float fexp2(float x) { return __builtin_amdgcn_exp2f(x); }
__device__ __forceinline__ float silu_f(float z) { return z * __builtin_amdgcn_rcpf(1.0f + fexp2(-LOG2E * z)); }
__device__ __forceinline__ float sigmoid_f(float z) { return __builtin_amdgcn_rcpf(1.0f + fexp2(-LOG2E * z)); }
__device__ __forceinline__ int t5_bucket_dev(int d) {
    if (d < 16) return d < 0 ? 0 : d;
    const float logd = logf((float)d / 16.0f);
    int large = 16 + (int)(logd / 4.852030263919617f * 16.0f);
    return large < 31 ? large : 31;
}

namespace pg8 {
constexpr int BM = 256, BK = 64, HALF = 128, HTB = HALF * BK * 2, NXCD = 8, WGM = 8;
__host__ __device__ __forceinline__ int lds_byte(int r, int c) { const int st = (r >> 4) * 2 + (c >> 5), rr = r & 15, cc = c & 31, ob = rr * 64 + cc * 2; return st * 1024 + (ob ^ (((ob >> 9) & 1) << 5)); }
__host__ __device__ __forceinline__ void stage_rc(int b, int& R, int& C) { const int st = b / 1024, sb = b % 1024, swz = sb ^ (((sb >> 9) & 1) << 5); R = (st >> 1) * 16 + swz / 64; C = (st & 1) * 32 + (swz % 64) / 2; }
__host__ __device__ __forceinline__ int perm32(int rho) { const int n = rho >> 4, i = rho & 15; return 8 * (i >> 2) + 4 * n + (i & 3); }
struct Unit { int pm, pn, pb; };
struct Gemm { const bf16_t* A; const bf16_t* Bt; int M, N, K, lda; size_t bstepA, bstepB; };
struct StaticOrder {
    int nM, nN, nwg, G, c;
    __host__ __device__ __forceinline__ void init(int M, int N, int G_, int c_) { nM = M / BM; nN = N / BM; nwg = nM * nN; G = G_; c = c_; }
    __host__ __device__ bool next(int i, Unit& u) const {
        const long L = (long)i * G + c; if (L >= nwg) return false;
        int wgid = (int)L; { const int q = nwg / NXCD, r = nwg % NXCD, xcd = wgid % NXCD, off = wgid / NXCD; wgid = (xcd < r ? xcd * (q + 1) : r * (q + 1) + (xcd - r) * q) + off; }
        const int nig = WGM * nN, gid = wgid / nig, fm = gid * WGM, gsz = (nM - fm) < WGM ? (nM - fm) : WGM;
        u.pm = fm + ((wgid % nig) % gsz); u.pn = (wgid % nig) / gsz; u.pb = 0; return true;
    }
    __device__ __forceinline__ void a_ready(const Unit&) const {}
    __device__ __forceinline__ void done(const Unit&) const {}
};
struct BatchOrder4 {
    StaticOrder base;
    __device__ __forceinline__ bool next(int i, Unit& u) const { if (!base.next(i >> 2, u)) return false; u.pb = i & 3; return true; }
    __device__ __forceinline__ void a_ready(const Unit&) const {}
    __device__ __forceinline__ void done(const Unit&) const {}
};
template <class Epi, class Sched>
__device__ __forceinline__ void gemm_phase(LAS unsigned char* lds, const Gemm g, const Sched& S, const Epi& E) {
    const int tid = otid(), wid = __builtin_amdgcn_readfirstlane(tid >> 6), lane = tid & 63, wr = wid >> 2, wc = wid & 3, fr = lane & 15, fq = lane >> 4;
    const int K = g.K, nt = K / BK, lda = g.lda;
    unsigned voffA[2], voffB[2];
#pragma unroll
    for (int i = 0; i < 2; ++i) { int R, C; stage_rc(tid * 16 + i * 8192, R, C); const int Rb = (R & ~31) + perm32(R & 31);
        voffA[i] = (unsigned)(R * lda + C) * 2u; voffB[i] = (unsigned)(Rb * K + C) * 2u; }
    const size_t kstep = (size_t)(BK * 2);
    const size_t hstepA = (size_t)HALF * lda * 2, hstepB = (size_t)HALF * K * 2;
    const size_t tstepA = 2 * hstepA, tstepB = 2 * hstepB;
    const unsigned ldsw = (unsigned)wid * 1024u;
    const int aoff = lds_byte(wr * 64 + fr, fq * 8), boff = lds_byte(wc * 32 + fr, fq * 8);
#define PG8_SA(b, h) (((b) * 2 + (h)) * HTB)
#define PG8_SB(b, h) ((4 + (b) * 2 + (h)) * HTB)
#define PG8_STAGE(bufoff, gbase, voff) do { _Pragma("unroll") for (int _i = 0; _i < 2; ++_i) \
        __builtin_amdgcn_global_load_lds((const unsigned*)((const char*)(gbase) + (voff)[_i]), (LAS unsigned*)(lds + (bufoff) + ldsw + _i * 8192), 16, 0, 0); } while (0)
#define PG8_LDA(dst, b, h) do { _Pragma("unroll") for (int m = 0; m < 4; ++m) _Pragma("unroll") for (int k = 0; k < 2; ++k) dst[m][k] = *(const LAS bf16x8*)(lds + PG8_SA(b, h) + aoff + m * 2048 + k * 1024); } while (0)
#define PG8_LDB(dst, b, h) do { _Pragma("unroll") for (int n = 0; n < 2; ++n) _Pragma("unroll") for (int k = 0; k < 2; ++k) dst[n][k] = *(const LAS bf16x8*)(lds + PG8_SB(b, h) + boff + n * 2048 + k * 1024); } while (0)
#define PG8_MMA(ai, bj, At, Bt) do { __builtin_amdgcn_s_setprio(1); _Pragma("unroll") for (int m = 0; m < 4; ++m) _Pragma("unroll") for (int n = 0; n < 2; ++n) _Pragma("unroll") for (int k = 0; k < 2; ++k) \
        acc[ai][bj][m][n] = __builtin_amdgcn_mfma_f32_16x16x32_bf16(Bt[n][k], At[m][k], acc[ai][bj][m][n], 0, 0, 0); __builtin_amdgcn_s_setprio(0); } while (0)
#define PG8_WAIT_V(n) asm volatile("s_waitcnt vmcnt(" #n ")" ::: "memory")
#define PG8_WAIT_L(n) asm volatile("s_waitcnt lgkmcnt(" #n ")" ::: "memory")
#define PG8_BAR __builtin_amdgcn_s_barrier()
#define PG8_SCHED __builtin_amdgcn_sched_barrier(0)
    Unit cur, nxt; int ui = 0;
    if (!S.next(0, cur)) return;
    f32x4 acc[2][2][4][2];
#pragma unroll
    for (int a = 0; a < 2; ++a)
#pragma unroll
        for (int b = 0; b < 2; ++b)
#pragma unroll
            for (int m = 0; m < 4; ++m)
#pragma unroll
                for (int n = 0; n < 2; ++n) acc[a][b][m][n] = (f32x4){0.f, 0.f, 0.f, 0.f};
    bf16x8 At[4][2], B0[2][2], B1[2][2];
    const char* cA = (const char*)g.A + (size_t)cur.pm * tstepA + (size_t)cur.pb * g.bstepA; const char* cB = (const char*)g.Bt + (size_t)cur.pn * tstepB + (size_t)cur.pb * g.bstepB;
    S.a_ready(cur);
    PG8_STAGE(PG8_SB(0, 0), cB, voffB); PG8_STAGE(PG8_SB(0, 1), cB + hstepB, voffB); PG8_STAGE(PG8_SA(0, 0), cA, voffA); PG8_STAGE(PG8_SA(0, 1), cA + hstepA, voffA);
    if (wr == 1) PG8_BAR;
    PG8_WAIT_V(2); PG8_BAR;
    PG8_STAGE(PG8_SB(1, 0), cB + kstep, voffB); PG8_STAGE(PG8_SA(1, 0), cA + kstep, voffA); PG8_STAGE(PG8_SB(1, 1), cB + hstepB + kstep, voffB);
    PG8_WAIT_V(6); PG8_BAR;
    for (;;) {
        const bool has_next = S.next(ui + 1, nxt);
        const char* nA = has_next ? (const char*)g.A + (size_t)nxt.pm * tstepA + (size_t)nxt.pb * g.bstepA : cA; const char* nB = has_next ? (const char*)g.Bt + (size_t)nxt.pn * tstepB + (size_t)nxt.pb * g.bstepB : cB;
        for (int t = 0; t < nt; t += 2) {
            const bool last = (t == nt - 2);
            const char* a1 = cA + (size_t)(t + 1) * kstep;
            const char* a2 = last ? nA : cA + (size_t)(t + 2) * kstep; const char* b2 = last ? nB : cB + (size_t)(t + 2) * kstep;
            const char* a3 = a2 + kstep; const char* b3 = b2 + kstep;
            if (last && has_next) S.a_ready(nxt);
            PG8_LDB(B0, 0, 0); PG8_LDB(B1, 0, 1); PG8_SCHED; PG8_LDA(At, 0, 0); PG8_STAGE(PG8_SA(1, 1), a1 + hstepA, voffA);
            PG8_WAIT_V(8); PG8_WAIT_L(0); PG8_BAR; PG8_MMA(0, 0, At, B0); PG8_MMA(0, 1, At, B1); PG8_BAR; PG8_SCHED;
            PG8_LDA(At, 0, 1); PG8_STAGE(PG8_SB(0, 0), b2, voffB); PG8_STAGE(PG8_SB(0, 1), b2 + hstepB, voffB); PG8_STAGE(PG8_SA(0, 0), a2, voffA);
            PG8_WAIT_V(8); PG8_WAIT_L(0); PG8_BAR; PG8_MMA(1, 0, At, B0); PG8_MMA(1, 1, At, B1); PG8_BAR; PG8_SCHED;
            PG8_LDB(B0, 1, 0); PG8_LDB(B1, 1, 1); PG8_SCHED; PG8_LDA(At, 1, 0); PG8_STAGE(PG8_SA(0, 1), a2 + hstepA, voffA);
            PG8_WAIT_V(8); PG8_WAIT_L(0); PG8_BAR; PG8_MMA(0, 0, At, B0); PG8_MMA(0, 1, At, B1); PG8_BAR; PG8_SCHED;
            PG8_LDA(At, 1, 1); PG8_STAGE(PG8_SB(1, 0), b3, voffB); PG8_STAGE(PG8_SB(1, 1), b3 + hstepB, voffB); PG8_STAGE(PG8_SA(1, 0), a3, voffA);
            PG8_WAIT_V(8); PG8_WAIT_L(0); PG8_BAR; PG8_MMA(1, 0, At, B0); PG8_MMA(1, 1, At, B1); PG8_BAR; PG8_SCHED;
        }
        if (wr == 0) PG8_BAR;
        E(acc, cur, wr, wc, fr, fq); S.done(cur);
        if (!has_next) break;
#pragma unroll
        for (int a = 0; a < 2; ++a)
#pragma unroll
            for (int b = 0; b < 2; ++b)
#pragma unroll
                for (int m = 0; m < 4; ++m)
#pragma unroll
                    for (int n = 0; n < 2; ++n) acc[a][b][m][n] = (f32x4){0.f, 0.f, 0.f, 0.f};
        cur = nxt; cA = nA; cB = nB; ++ui;
        if (wr == 1) PG8_BAR;
    }
    PG8_WAIT_V(0);
    PG8_BAR;
#undef PG8_SA
#undef PG8_SB
#undef PG8_STAGE
#undef PG8_LDA
#undef PG8_LDB
#undef PG8_MMA
#undef PG8_WAIT_V
#undef PG8_WAIT_L
#undef PG8_BAR
#undef PG8_SCHED
}

struct EpiStore {
    bf16_t* O; int ldc; int act;
    __device__ __forceinline__ void operator()(const f32x4 (&acc)[2][2][4][2], const Unit& u, int wr, int wc, int fr, int fq) const {
        const int row0 = u.pm * BM + wr * 64 + fr; const int col0 = u.pn * BM + wc * 32 + 8 * fq;
#pragma unroll
        for (int ai = 0; ai < 2; ++ai)
#pragma unroll
            for (int m = 0; m < 4; ++m) { bf16_t* rowp = O + (size_t)(row0 + ai * HALF + m * 16) * ldc + col0;
#pragma unroll
                for (int bj = 0; bj < 2; ++bj) { f32x4 v0 = acc[ai][bj][m][0], v1 = acc[ai][bj][m][1];
                    if (act == 1) {
#pragma unroll
                        for (int e = 0; e < 4; ++e) { v0[e] = sigmoid_f(v0[e]); v1[e] = sigmoid_f(v1[e]); }
                    }
                    u32x4 w; w.x = pk2(v0[0], v0[1]); w.y = pk2(v0[2], v0[3]); w.z = pk2(v1[0], v1[1]); w.w = pk2(v1[2], v1[3]);
                    *(u32x4*)(rowp + bj * HALF) = w; } }
    }
};
struct EpiStoreNorm {
    bf16_t* O; const float* qga; const float* qgb; const float* qgd; LAS float* P;
    __device__ __forceinline__ void operator()(const f32x4 (&acc)[2][2][4][2], const Unit& u, int wr, int wc, int fr, int fq) const {
        const int wid = wr * 4 + wc;
        const int row0 = u.pm * BM + wr * 64 + fr; const int col0 = u.pn * BM + wc * 32 + 8 * fq;
        const float qs = 0.125f * LOG2E;
        const float* gp[2]; float sc[2];
#pragma unroll
        for (int bj = 0; bj < 2; ++bj) {
            const int c = u.pn * BM + bj * HALF + (wc >> 1) * 64;
            gp[bj] = nullptr; sc[bj] = 1.0f;
            if (c < 512) { gp[bj] = qga; sc[bj] = qs; } else if (c < 1024) gp[bj] = qga + 64;
            else if (c >= BQ && c < BQ + 1536) { gp[bj] = qgb; sc[bj] = qs; } else if (c >= BKK && c < BKK + 1536) gp[bj] = qgb + 64;
            else if (c >= DQ && c < DQ + 512) { gp[bj] = qgd; sc[bj] = qs; } else if (c >= DK && c < DK + 128) gp[bj] = qgd + 64;
        }
        unsigned pown = (unsigned)((wid * 256 + fr) * 4), ppar = (unsigned)(((wid ^ 1) * 256 + fr) * 4);
        asm volatile("" : "+v"(pown), "+v"(ppar));
        LAS unsigned char* Pb = (LAS unsigned char*)P;
#pragma unroll
        for (int ai = 0; ai < 2; ++ai)
#pragma unroll
            for (int m = 0; m < 4; ++m)
#pragma unroll
                for (int bj = 0; bj < 2; ++bj) {
                    const f32x4 v0 = acc[ai][bj][m][0], v1 = acc[ai][bj][m][1];
                    float t = v0[0] * v0[0] + v0[1] * v0[1] + v0[2] * v0[2] + v0[3] * v0[3] + v1[0] * v1[0] + v1[1] * v1[1] + v1[2] * v1[2] + v1[3] * v1[3];
                    t += __shfl_xor(t, 16); t += __shfl_xor(t, 32);
                    if (fq == 0) *(LAS float*)(Pb + pown + ((ai * 4 + m) * 2 + bj) * 64) = t;
                }
        asm volatile("s_waitcnt lgkmcnt(0)" ::: "memory"); __builtin_amdgcn_s_barrier(); asm volatile("" ::: "memory");
#pragma unroll
        for (int bj = 0; bj < 2; ++bj) {
            f32x4 g0 = (f32x4){1.f, 1.f, 1.f, 1.f}, g1 = g0;
            if (gp[bj]) { const float* g = gp[bj] + (wc & 1) * 32 + fq * 8; g0 = *(const f32x4*)g * sc[bj]; g1 = *(const f32x4*)(g + 4) * sc[bj]; }
#pragma unroll
            for (int ai = 0; ai < 2; ++ai)
#pragma unroll
                for (int m = 0; m < 4; ++m) {
                    f32x4 v0 = acc[ai][bj][m][0], v1 = acc[ai][bj][m][1];
                    if (gp[bj]) {
                        const float tot = *(const LAS float*)(Pb + pown + ((ai * 4 + m) * 2 + bj) * 64) + *(const LAS float*)(Pb + ppar + ((ai * 4 + m) * 2 + bj) * 64);
                        const float rs = rsqrtf(tot * (1.0f / 64.0f) + 1e-6f);
#pragma unroll
                        for (int e = 0; e < 4; ++e) { v0[e] = v0[e] * rs * g0[e]; v1[e] = v1[e] * rs * g1[e]; }
                    }
                    u32x4 w; w.x = pk2(v0[0], v0[1]); w.y = pk2(v0[2], v0[3]); w.z = pk2(v1[0], v1[1]); w.w = pk2(v1[2], v1[3]);
                    *(u32x4*)(O + (size_t)(row0 + ai * HALF + m * 16) * NP1 + col0 + bj * HALF) = w;
                }
        }
    }
};
struct EpiBranch {
    bf16_t* MGb; const bf16_t* G; int ldg;
    __device__ __forceinline__ void operator()(const f32x4 (&acc)[2][2][4][2], const Unit& u, int wr, int wc, int fr, int fq) const {
        const int row0 = u.pm * BM + wr * 64 + fr; const int col0 = u.pn * BM + wc * 32 + 8 * fq;
        const bf16_t* Gb = G + u.pb * 1024; const bool first = (u.pb == 0);
#pragma unroll
        for (int ai = 0; ai < 2; ++ai)
#pragma unroll
            for (int m = 0; m < 4; ++m) { const size_t row = (size_t)(row0 + ai * HALF + m * 16);
                u32x4 gw[2], ow[2];
#pragma unroll
                for (int bj = 0; bj < 2; ++bj) { const int col = col0 + bj * HALF;
                    gw[bj] = *(const u32x4*)(Gb + row * ldg + col);
                    ow[bj] = first ? (u32x4){0u, 0u, 0u, 0u} : *(const u32x4*)(MGb + row * 1024 + col); }
#pragma unroll
                for (int bj = 0; bj < 2; ++bj) { const int col = col0 + bj * HALF;
                    float gf[8], of[8]; unpack8(gw[bj], gf); unpack8(ow[bj], of);
                    const f32x4 v0 = acc[ai][bj][m][0], v1 = acc[ai][bj][m][1];
#pragma unroll
                    for (int e = 0; e < 4; ++e) { of[e] += v0[e] * gf[e]; of[4 + e] += v1[e] * gf[4 + e]; }
                    *(u32x4*)(MGb + row * 1024 + col) = pack8(of); } }
    }
};
struct EpiOut {
    const float* xin; float* out;
    __device__ __forceinline__ void operator()(const f32x4 (&acc)[2][2][4][2], const Unit& u, int wr, int wc, int fr, int fq) const {
        const int row0 = u.pm * BM + wr * 64 + fr; const int col0 = u.pn * BM + wc * 32 + 8 * fq;
#pragma unroll
        for (int ai = 0; ai < 2; ++ai)
#pragma unroll
            for (int m = 0; m < 4; ++m) { const size_t row = (size_t)(row0 + ai * HALF + m * 16);
#pragma unroll
                for (int bj = 0; bj < 2; ++bj) { const size_t off = row * 1024 + col0 + bj * HALF;
                    const f32x4 x0 = *(const f32x4*)(xin + off), x1 = *(const f32x4*)(xin + off + 4);
                    *(f32x4*)(out + off) = x0 + acc[ai][bj][m][0]; *(f32x4*)(out + off + 4) = x1 + acc[ai][bj][m][1]; } }
    }
};
}


#define XB_TMO      128
#define XB_XCNT(j)  (256  + 64 * (j))
#define XB_XSUB(j)  (1280 + 64 * (j))
#define XB_XGEN(j)  (2304 + 64 * (j))
#define XB_TOP      3328
#define XB_TOPGEN   3392
#define XCD_BAR_WORDS 3456
#define XB_SPIN_CAP (1u << 22)
__device__ __forceinline__ unsigned xb_ld(unsigned* p)              { return __hip_atomic_load(p, __ATOMIC_RELAXED, __HIP_MEMORY_SCOPE_AGENT); }
__device__ __forceinline__ unsigned xb_add(unsigned* p, unsigned v) { return __hip_atomic_fetch_add(p, v, __ATOMIC_RELAXED, __HIP_MEMORY_SCOPE_AGENT); }
__device__ __forceinline__ unsigned xb_xcc_id() { return (unsigned)__builtin_amdgcn_s_getreg((3 << 11) | 20) & 0xFu; }
#define XB_SPIN(cond, bar) do { unsigned _sp = 0; while (cond) { __builtin_amdgcn_s_sleep(1); \
    if ((++_sp & 255u) == 0u) { if (xb_ld(&(bar)[XB_TMO])) break; if (_sp > XB_SPIN_CAP) { atomicAdd(&(bar)[XB_TMO], 1u); break; } } } } while (0)
struct XcdBarrier { unsigned* bar; unsigned x; volatile LAS unsigned* st; };
__device__ __forceinline__ XcdBarrier xcd_barrier_post(unsigned* bar, volatile LAS unsigned* st) {
    XcdBarrier b; b.bar = bar; b.x = xb_xcc_id(); b.st = st;
    if (threadIdx.x == 0) (void)xb_add(&bar[XB_XCNT(b.x)], 1u);
    return b;
}
__device__ __forceinline__ void xcd_barrier_complete(unsigned* bar, unsigned x, unsigned& nloc, unsigned& nx) {
    const unsigned G = gridDim.x * gridDim.y * gridDim.z;
    unsigned sum, cnt, mine, sp = 0u;
    for (;;) {
        sum = 0u; cnt = 0u; mine = 0u;
#pragma unroll
        for (unsigned j = 0; j < 16; ++j) { const unsigned c = xb_ld(&bar[XB_XCNT(j)]); sum += c; cnt += (c > 0u) ? 1u : 0u; mine = (j == x) ? c : mine; }
        if (sum == G) break;
        __builtin_amdgcn_s_sleep(1);
        if ((++sp & 255u) == 0u) { if (xb_ld(&bar[XB_TMO])) break; if (sp > XB_SPIN_CAP) { atomicAdd(&bar[XB_TMO], 1u); break; } }
    }
    nloc = mine > 0u ? mine : 1u; nx = cnt > 0u ? cnt : 1u;
}
__device__ __forceinline__ void xcd_barrier(const XcdBarrier& b) {
    asm volatile("s_waitcnt vmcnt(0)" ::: "memory");
    __syncthreads();
    if (threadIdx.x == 0) {
        unsigned* bar = b.bar;
        __builtin_amdgcn_s_waitcnt(0);
        unsigned nloc = b.st[0], nx = b.st[1];
        if (nloc == 0u) { xcd_barrier_complete(bar, b.x, nloc, nx); b.st[0] = nloc; b.st[1] = nx; }
        const unsigned old = xb_add(&bar[XB_XSUB(b.x)], 1u);
        const unsigned gen = old / nloc;
        if (old + 1u == (gen + 1u) * nloc) {
            __builtin_amdgcn_fence(__ATOMIC_RELEASE, "agent");
            asm volatile("s_waitcnt vmcnt(0)" ::: "memory");
            const unsigned og = xb_add(&bar[XB_TOP], 1u);
            const unsigned tg = og / nx;
            if (og + 1u == (tg + 1u) * nx) xb_add(&bar[XB_TOPGEN], 1u);
            else XB_SPIN(xb_ld(&bar[XB_TOPGEN]) == tg, bar);
            __builtin_amdgcn_fence(__ATOMIC_ACQUIRE, "agent");
            xb_add(&bar[XB_XGEN(b.x)], 1u);
            asm volatile("s_waitcnt vmcnt(0)" ::: "memory");
        } else {
            XB_SPIN(xb_ld(&bar[XB_XGEN(b.x)]) == gen, bar);
            __builtin_amdgcn_fence(__ATOMIC_ACQUIRE, "agent");
            asm volatile("s_waitcnt vmcnt(0)" ::: "memory");
        }
    }
    __syncthreads();
}

__device__ __forceinline__ int next_unit(int* counter, LAS unsigned char* lds) {
    LAS int* slot = (LAS int*)(lds + LDS_MISC);
    __syncthreads();
    if (otid() == 0) *slot = atomicAdd(counter, 1);
    __syncthreads();
    return __builtin_amdgcn_readfirstlane(*slot);
}

__device__ __forceinline__ void tr_tile(LAS unsigned char* lds, const float* src, int pitch, int K, int c0, int nc, bf16_t* dst, int tile) {
    LAS float* T = (LAS float*)lds;
    const int nkt = K / 64; const int kt = tile % nkt, ntl = tile / nkt; const int k0 = kt * 64, n0 = ntl * 64;
    const int tid = otid();
    __syncthreads();
    {
        const int r = (tid >> 4), c4 = (tid & 15) * 4;
        f32x4 v0 = (f32x4){0.f, 0.f, 0.f, 0.f}, v1 = v0;
        if (n0 + c4 + 4 <= nc) { v0 = *(const f32x4*)(src + (size_t)(k0 + r) * pitch + c0 + n0 + c4); v1 = *(const f32x4*)(src + (size_t)(k0 + r + 32) * pitch + c0 + n0 + c4); }
        T[r * 65 + c4 + 0] = v0[0]; T[r * 65 + c4 + 1] = v0[1]; T[r * 65 + c4 + 2] = v0[2]; T[r * 65 + c4 + 3] = v0[3];
        T[(r + 32) * 65 + c4 + 0] = v1[0]; T[(r + 32) * 65 + c4 + 1] = v1[1]; T[(r + 32) * 65 + c4 + 2] = v1[2]; T[(r + 32) * 65 + c4 + 3] = v1[3];
    }
    __syncthreads();
    const int n = tid >> 3, kc = (tid & 7) * 8;
    if (n0 + n < nc) {
        float f[8];
#pragma unroll
        for (int i = 0; i < 8; ++i) f[i] = T[(kc + i) * 65 + n];
        *(u32x4*)(dst + (size_t)(n0 + n) * K + k0 + kc) = pack8(f);
    }
}

__device__ __forceinline__ void setup_phase(const Params& p, const WsMap& wm, LAS unsigned char* lds) {
    constexpr int T_WIN = 16 * 152, T_WG = 16 * 64, T_WBR = 4 * 8 * 16, T_WO = 16 * 16, T_WQB = 4 * 12, T_WKVB = 2 * 16;
    constexpr int T_LAYER = T_WIN + T_WG + T_WBR + T_WO + T_WQB + T_WKVB;
    for (int t = obid(); t < DEPTH * T_LAYER; t += gridDim.x) {
        const int l = t / T_LAYER; int r = t % T_LAYER;
        if (r < T_WIN) {
            const float* src = p.w_in + (size_t)l * DM * NIN; bf16_t* dst = (bf16_t*)(p.ws + wm.winT) + (size_t)l * NP1 * DM;
            int c0, nc, d0, t = r;
            if (t < 16 * 37) { c0 = 0; nc = 2344; d0 = 0; }
            else if ((t -= 16 * 37) < 16 * 80) { c0 = 2344; nc = 5120; d0 = BQ; }
            else if ((t -= 16 * 80) < 16 * 4) { c0 = 7464; nc = 256; d0 = CQ; }
            else if ((t -= 16 * 4) < 16 * 2) { c0 = 7720; nc = 128; d0 = CKV; }
            else if ((t -= 16 * 2) < 16 * 1) { c0 = 7848; nc = 32; d0 = CPE; }
            else if ((t -= 16 * 1) < 16 * 8) { c0 = 7880; nc = 512; d0 = CZ; }
            else { t -= 16 * 8; c0 = 8392; nc = 1280; d0 = DQ; }
            tr_tile(lds, src, NIN, DM, c0, nc, dst + (size_t)d0 * DM, t); continue;
        }
        r -= T_WIN;
        if (r < T_WG) { tr_tile(lds, p.w_in + (size_t)l * DM * NIN, NIN, DM, NHC, 4096, (bf16_t*)(p.ws + wm.wgT) + (size_t)l * 4096 * DM, r); continue; }
        r -= T_WG;
        if (r < T_WBR) { const int b = r / (8 * 16); tr_tile(lds, p.w_branch + ((size_t)l * 4 + b) * 512 * 1024, 1024, 512, 0, 1024, (bf16_t*)(p.ws + wm.wbrT) + ((size_t)l * 4 + b) * 1024 * 512, r % (8 * 16)); continue; }
        r -= T_WBR;
        if (r < T_WO) { tr_tile(lds, p.w_out + (size_t)l * 1024 * 1024, 1024, 1024, 0, 1024, (bf16_t*)(p.ws + wm.woT) + (size_t)l * 1024 * 1024, r); continue; }
        r -= T_WO;
        if (r < T_WQB) { tr_tile(lds, p.w_q_b + (size_t)l * 256 * 768, 768, 256, 0, 768, (bf16_t*)(p.ws + wm.wqbT) + (size_t)l * 768 * 256, r); continue; }
        r -= T_WQB;
        tr_tile(lds, p.w_kv_b + (size_t)l * 128 * 1024, 1024, 128, 0, 1024, (bf16_t*)(p.ws + wm.wkvbT) + (size_t)l * 1024 * 128, r);
    }
    const int gtid = obid() * NTHREADS + otid(), gsz = gridDim.x * NTHREADS;
    unsigned char* lut = p.ws + wm.lut;
    for (int d = gtid; d < SEQ; d += gsz) lut[d] = (unsigned char)t5_bucket_dev(d);
    {
        float* biasd = (float*)(p.ws + wm.biasd);
        for (int e = gtid; e < NBH * SEQ; e += gsz) { const int col = e / SEQ, d = e % SEQ; biasd[e] = p.rel_bias[t5_bucket_dev(d) * NBH + col] * LOG2E; }
        if (obid() == 0 && otid() < 64) {
            const int lane = otid();
            float bm = 0.f;
            for (int i = lane; i < 32 * NBH; i += 64) bm = fmaxf(bm, fabsf(p.rel_bias[i]));
#pragma unroll
            for (int o = 1; o < 64; o <<= 1) bm = fmaxf(bm, __shfl_xor(bm, o));
            float* bnd = (float*)(p.ws + wm.bnd);
            for (int l = 0; l < DEPTH; ++l)
                for (int br = 0; br < 4; ++br) {
                    const float* g = (br == 0) ? p.qga : (br == 1) ? p.qgb : (br == 2) ? p.qgc : p.qgd; const int dim = (br == 2) ? 96 : 64;
                    float a = 0.f, b = 0.f;
                    for (int i = lane; i < dim; i += 64) { a = fmaxf(a, fabsf(g[(l * 2) * dim + i])); b = fmaxf(b, fabsf(g[(l * 2 + 1) * dim + i])); }
#pragma unroll
                    for (int o = 1; o < 64; o <<= 1) { a = fmaxf(a, __shfl_xor(a, o)); b = fmaxf(b, __shfl_xor(b, o)); }
                    if (lane == 0) bnd[l * 4 + br] = sqrtf((float)dim) * a * b * LOG2E * 1.03f + ((br == 2) ? 0.f : bm * LOG2E) + 0.25f;
                }
        }
    }
    float* rope = (float*)(p.ws + wm.rope);
    for (int e = gtid; e < SEQ * 16; e += gsz) {
        const int pos = e >> 4, i = e & 15;
        const float freq = (float)pow(10000.0, -(double)i / 16.0);
        const float ang = (float)pos * freq;
        rope[pos * 32 + i] = (float)cos((double)ang); rope[pos * 32 + 16 + i] = (float)sin((double)ang);
    }
}

__device__ __forceinline__ void p0_phase(const float* xin, const float* gain, bf16_t* xb) {
    const int lane = otid() & 63; const int gw = (obid() * NTHREADS + otid()) >> 6, nw = (gridDim.x * NTHREADS) >> 6;
    f32x4 g[4];
#pragma unroll
    for (int i = 0; i < 4; ++i) g[i] = *(const f32x4*)(gain + i * 256 + lane * 4);
    for (int row = gw; row < TT; row += nw) {
        const float* xr = xin + (size_t)row * DM; f32x4 v[4]; float ss = 0.f;
#pragma unroll
        for (int i = 0; i < 4; ++i) { v[i] = *(const f32x4*)(xr + i * 256 + lane * 4); ss += v[i][0] * v[i][0] + v[i][1] * v[i][1] + v[i][2] * v[i][2] + v[i][3] * v[i][3]; }
#pragma unroll
        for (int o = 1; o < 64; o <<= 1) ss += __shfl_xor(ss, o);
        const float rs = rsqrtf(ss * (1.0f / DM) + 1e-6f);
#pragma unroll
        for (int i = 0; i < 4; ++i) { u32x2 w; w.x = pk2(v[i][0] * rs * g[i][0], v[i][1] * rs * g[i][1]); w.y = pk2(v[i][2] * rs * g[i][2], v[i][3] * rs * g[i][3]);
            *(u32x2*)(xb + (size_t)row * DM + i * 256 + lane * 4) = w; }
    }
}

__device__ __forceinline__ void norm8(u32x4& w, const float (&g)[8], int nl, float inv_gs, bool act) {
    float f[8]; unpack8(w, f); float ss = 0.f;
#pragma unroll
    for (int i = 0; i < 8; ++i) ss += f[i] * f[i];
    if (!act) ss = 0.f;
    ss += __shfl_xor(ss, 1); ss += __shfl_xor(ss, 2); ss += __shfl_xor(ss, 4);
    if (nl > 8) ss += __shfl_xor(ss, 8);
    if (nl > 16) ss += __shfl_xor(ss, 16);
    const float rs = rsqrtf(ss * inv_gs + 1e-6f);
#pragma unroll
    for (int i = 0; i < 8; ++i) f[i] = f[i] * rs * g[i];
    w = pack8(f);
}
__device__ __forceinline__ void norm_phase(const Params& p, bf16_t* H, int Tc, int l) {
    const int lane = otid() & 63; const int gw = (obid() * NTHREADS + otid()) >> 6, nw = (gridDim.x * NTHREADS) >> 6;
    float gCq[8], gCkv[8];
#pragma unroll
    for (int i = 0; i < 8; ++i) { gCq[i] = p.cq_gain[l * 256 + (lane & 31) * 8 + i]; gCkv[i] = p.ckv_gain[l * 128 + (lane & 15) * 8 + i]; }
    const bool isq = lane < 32;
    const bool act = lane < 48;
    for (int row = gw; row < Tc; row += nw) {
        bf16_t* ptr = H + (size_t)row * NP1 + (isq ? CQ + lane * 8 : CKV + (lane - 32) * 8);
        u32x4 w = act ? *(const u32x4*)ptr : (u32x4){0u, 0u, 0u, 0u};
        float f[8]; unpack8(w, f); float ss = 0.f;
#pragma unroll
        for (int i = 0; i < 8; ++i) ss += f[i] * f[i];
        ss += __shfl_xor(ss, 1); ss += __shfl_xor(ss, 2); ss += __shfl_xor(ss, 4); ss += __shfl_xor(ss, 8);
        const float s16 = __shfl_xor(ss, 16);
        if (isq) ss += s16;
        const float rs = rsqrtf(ss * (isq ? (1.0f / 256.0f) : (1.0f / 128.0f)) + 1e-6f);
#pragma unroll
        for (int i = 0; i < 8; ++i) f[i] = f[i] * rs * (isq ? gCq[i] : gCkv[i]);
        if (act) *(u32x4*)ptr = pack8(f);
    }
}

__device__ __forceinline__ void mla_phase(const Params& p, const WsMap& wm, const bf16_t* H, bf16_t* QC, bf16_t* KC, const bf16_t* KV, int Tc, int l) {
    const int lane = otid() & 63; const int gw = (obid() * NTHREADS + otid()) >> 6, nw = (gridDim.x * NTHREADS) >> 6;
    const float* rope = (const float*)(p.ws + wm.rope);
    const int sub = lane & 15, hl = lane >> 4;
    const float qscale = 0.10206207261596577f * LOG2E;
    const bool act = sub < 12; const int gsub = act ? sub : 0;
    float gq[8], gk[8];
#pragma unroll
    for (int i = 0; i < 8; ++i) { gq[i] = p.qgc[(l * 2 + 0) * 96 + gsub * 8 + i] * qscale; gk[i] = p.qgc[(l * 2 + 1) * 96 + gsub * 8 + i]; }
    for (int row = gw; row < Tc; row += nw) {
        const int pos = row & (SEQ - 1);
        u32x4 w[4];
#pragma unroll
        for (int part = 0; part < 4; ++part) {
            const int isk = part >> 1, h = (part & 1) * 4 + hl;
            w[part] = (u32x4){0u, 0u, 0u, 0u};
            if (act) {
                if (!isk) w[part] = *(const u32x4*)(QC + (size_t)row * 768 + h * 96 + sub * 8);
                else if (sub < 8) w[part] = *(const u32x4*)(KV + (size_t)row * 1024 + h * 128 + sub * 8);
                else w[part] = *(const u32x4*)(H + (size_t)row * NP1 + CPE + (sub - 8) * 8);
            }
        }
        const float* cs = rope + pos * 32 + (sub & 1) * 8;
        const f32x4 c0 = *(const f32x4*)cs, c1 = *(const f32x4*)(cs + 4), s0 = *(const f32x4*)(cs + 16), s1 = *(const f32x4*)(cs + 20);
        const float cc[8] = {c0[0], c0[1], c0[2], c0[3], c1[0], c1[1], c1[2], c1[3]};
        const float sn[8] = {s0[0], s0[1], s0[2], s0[3], s1[0], s1[1], s1[2], s1[3]};
#pragma unroll
        for (int part = 0; part < 4; ++part) {
            const int isk = part >> 1, h = (part & 1) * 4 + hl;
            float f[8]; unpack8(w[part], f); float ss = 0.f;
#pragma unroll
            for (int i = 0; i < 8; ++i) ss += f[i] * f[i];
            ss += __shfl_xor(ss, 1); ss += __shfl_xor(ss, 2); ss += __shfl_xor(ss, 4); ss += __shfl_xor(ss, 8);
            const float rs = rsqrtf(ss * (1.0f / 96.0f) + 1e-6f);
#pragma unroll
            for (int i = 0; i < 8; ++i) f[i] = f[i] * rs * (isk ? gk[i] : gq[i]);
#pragma unroll
            for (int i = 0; i < 8; ++i) {
                const float other = __shfl_xor(f[i], 2);
                if (sub >= 8 && sub < 12) f[i] = (sub < 10) ? (f[i] * cc[i] - other * sn[i]) : (f[i] * cc[i] + other * sn[i]);
            }
            if (act) { bf16_t* dst = (isk ? KC : QC) + (size_t)row * 768 + h * 96 + sub * 8; *(u32x4*)dst = pack8(f); }
        }
    }
}

__device__ __forceinline__ void indexer_unit(LAS unsigned char* lds, const bf16_t* H, unsigned short* MASK16, int bl, int qb) {
    LAS unsigned* hist = (LAS unsigned*)lds;
    LAS unsigned* prefix = (LAS unsigned*)(lds + 32768);
    LAS unsigned* need = (LAS unsigned*)(lds + 32768 + 128);
    const int tid = otid(), wid = __builtin_amdgcn_readfirstlane(tid >> 6), lane = tid & 63, lr = lane & 15, lg = lane >> 4;
    const int q0 = qb * 32; const size_t rowbase = (size_t)bl * SEQ;
    const int nks = (q0 + 31) / 128 + 1;
    __syncthreads();
    if (tid < 32) { prefix[tid] = 0u; need[tid] = 256u; }
    bf16x8 iq[2][8]; float iw[2][8];
#pragma unroll
    for (int qt = 0; qt < 2; ++qt) {
        const bf16_t* hr = H + (rowbase + q0 + qt * 16 + lr) * NP1;
#pragma unroll
        for (int h = 0; h < 8; ++h) iq[qt][h] = *(const bf16x8*)(hr + AIQ + h * 32 + lg * 8);
        const u32x4 w = *(const u32x4*)(hr + AIW); float f[8]; unpack8(w, f);
#pragma unroll
        for (int h = 0; h < 8; ++h) iw[qt][h] = f[h];
    }
    const int tq0 = q0 + lr, tq1 = q0 + 16 + lr;
    for (int pass = 0; pass < 5; ++pass) {
        if (pass < 4) { for (int i = tid; i < 32 * 256; i += NTHREADS) hist[i] = 0u; }
        __syncthreads();
        const unsigned pf0 = prefix[lr], pf1 = prefix[16 + lr];
        const unsigned th0 = (tq0 < 256) ? 0u : pf0, th1 = (tq1 < 256) ? 0u : pf1;
        const int shp = (pass == 0) ? 0 : (32 - 8 * pass), shd = (pass < 4) ? (24 - 8 * pass) : 0;
        for (int ks = 0; ks < nks; ++ks) {
            const int kb = ks * 128 + wid * 16;
            const bf16x8 ikf = *(const bf16x8*)(H + (rowbase + kb + lr) * NP1 + AIK + lg * 8);
            float sc[2][4];
#pragma unroll
            for (int qt = 0; qt < 2; ++qt) {
#pragma unroll
                for (int j = 0; j < 4; ++j) sc[qt][j] = 0.f;
#pragma unroll
                for (int h = 0; h < 8; ++h) {
                    f32x4 a = (f32x4){0.f, 0.f, 0.f, 0.f};
                    a = __builtin_amdgcn_mfma_f32_16x16x32_bf16(ikf, iq[qt][h], a, 0, 0, 0);
#pragma unroll
                    for (int j = 0; j < 4; ++j) sc[qt][j] += iw[qt][h] * fmaxf(a[j], 0.f);
                }
            }
            if (pass < 4) {
#pragma unroll
                for (int qt = 0; qt < 2; ++qt) {
                    const int tq = qt ? tq1 : tq0; const unsigned pf = qt ? pf1 : pf0;
#pragma unroll
                    for (int j = 0; j < 4; ++j) {
                        const int key = kb + lg * 4 + j;
                        const unsigned u = __float_as_uint(sc[qt][j] + 0.0f);
                        const unsigned k32 = (u & 0x80000000u) ? ~u : (u | 0x80000000u);
                        const bool ok = (key <= tq) && (pass == 0 || (k32 >> shp) == pf);
                        if (ok) __hip_atomic_fetch_add(&hist[(qt * 16 + lr) * 256 + ((k32 >> shd) & 255u)], 1u, __ATOMIC_RELAXED, __HIP_MEMORY_SCOPE_WORKGROUP);
                    }
                }
            } else {
                unsigned bits[2];
#pragma unroll
                for (int qt = 0; qt < 2; ++qt) {
                    const int tq = qt ? tq1 : tq0; const unsigned th = qt ? th1 : th0;
                    unsigned b = 0u;
#pragma unroll
                    for (int j = 0; j < 4; ++j) {
                        const int key = kb + lg * 4 + j;
                        const unsigned u = __float_as_uint(sc[qt][j] + 0.0f);
                        const unsigned k32 = (u & 0x80000000u) ? ~u : (u | 0x80000000u);
                        if ((key <= tq) && (k32 >= th)) b |= 1u << (lg * 4 + j);
                    }
                    b |= __shfl_xor(b, 16); b |= __shfl_xor(b, 32);
                    bits[qt] = b;
                }
                if (lg == 0) {
                    MASK16[(rowbase + tq0) * 512 + ks * 8 + wid] = (unsigned short)bits[0];
                    MASK16[(rowbase + tq1) * 512 + ks * 8 + wid] = (unsigned short)bits[1];
                }
            }
        }
        if (pass < 4) {
            __syncthreads();
            for (int r = 0; r < 4; ++r) {
                const int row = wid * 4 + r;
                const unsigned c0 = hist[row * 256 + 255 - 4 * lane], c1 = hist[row * 256 + 254 - 4 * lane], c2 = hist[row * 256 + 253 - 4 * lane], c3 = hist[row * 256 + 252 - 4 * lane];
                const unsigned cs = c0 + c1 + c2 + c3; unsigned incl = cs;
#pragma unroll
                for (int o = 1; o < 64; o <<= 1) { const unsigned t = __shfl_up(incl, o); if (lane >= o) incl += t; }
                const unsigned excl = incl - cs; const unsigned nd = need[row];
                if (excl < nd && nd <= incl) {
                    unsigned a = excl; int dg; unsigned nn;
                    if (a + c0 >= nd) { dg = 255 - 4 * lane; nn = nd - a; }
                    else { a += c0; if (a + c1 >= nd) { dg = 254 - 4 * lane; nn = nd - a; }
                        else { a += c1; if (a + c2 >= nd) { dg = 253 - 4 * lane; nn = nd - a; } else { a += c2; dg = 252 - 4 * lane; nn = nd - a; } } }
                    prefix[row] = (prefix[row] << 8) | (unsigned)dg; need[row] = nn;
                }
            }
            __syncthreads();
        }
    }
    __syncthreads();
}

__device__ __forceinline__ void wave_find(unsigned c, unsigned need, int lane, int& sl, unsigned& excl_at) {
    unsigned incl = c;
#pragma unroll
    for (int o = 1; o < 64; o <<= 1) { const unsigned t = __shfl_up(incl, o); if (lane >= o) incl += t; }
    const unsigned excl = incl - c;
    const unsigned long long b = __builtin_amdgcn_ballot_w64(excl < need && need <= incl);
    sl = b ? (int)__builtin_ctzll(b) : 63;
    excl_at = __shfl(excl, sl);
}
__device__ __forceinline__ void idx_scores(const bf16x8 ikf, const bf16x8 (&iq)[2][8], const float (&iw)[2][8], const bf16x8 (&iql)[2][2], float (&sc)[2][4]) {
#pragma unroll
    for (int qt = 0; qt < 2; ++qt) {
        f32x4 L = (f32x4){0.f, 0.f, 0.f, 0.f};
        L = __builtin_amdgcn_mfma_f32_16x16x32_bf16(ikf, iql[qt][0], L, 0, 0, 0);
        L = __builtin_amdgcn_mfma_f32_16x16x32_bf16(ikf, iql[qt][1], L, 0, 0, 0);
#pragma unroll
        for (int j = 0; j < 4; ++j) sc[qt][j] = L[j];
#pragma unroll
        for (int h = 0; h < 8; ++h) {
            f32x4 a = (f32x4){0.f, 0.f, 0.f, 0.f};
            a = __builtin_amdgcn_mfma_f32_16x16x32_bf16(ikf, iq[qt][h], a, 0, 0, 0);
#pragma unroll
            for (int j = 0; j < 4; ++j) sc[qt][j] = __builtin_fmaf(iw[qt][h], __builtin_fabsf(a[j]), sc[qt][j]);
        }
    }
}
__device__ __forceinline__ unsigned mono_key(float s) { const unsigned u = __float_as_uint(s + 0.0f); return u ^ ((unsigned)((int)u >> 31) | 0x80000000u); }
__device__ __forceinline__ float key_edge(unsigned kk) { return __uint_as_float((kk & 0x80000000u) ? (kk ^ 0x80000000u) : ~kk); }
constexpr int ICAP = 512;
__device__ __forceinline__ bool indexer_fast(LAS unsigned char* lds, const bf16_t* H, unsigned char* MASKB, int bl, int qb) {
    LAS unsigned* H11 = (LAS unsigned*)lds;
    LAS unsigned* KL = (LAS unsigned*)lds;
    LAS unsigned short* IL = (LAS unsigned short*)(lds + 65536);
    LAS unsigned char* LM = lds + 98304;
    LAS int* tbin = (LAS int*)(lds + LDS_MISC + 128);
    LAS unsigned* need1 = (LAS unsigned*)(lds + LDS_MISC + 256);
    LAS unsigned* cc = (LAS unsigned*)(lds + LDS_MISC + 384);
    LAS unsigned* ovf = (LAS unsigned*)(lds + LDS_MISC + 512);
    LAS unsigned* hist2 = (LAS unsigned*)(lds + LDS_MISC + 1024);
    const int tid = otid(), wid = __builtin_amdgcn_readfirstlane(tid >> 6), lane = tid & 63, lr = lane & 15, lg = lane >> 4;
    const int q0 = qb * 32; const size_t rowbase = (size_t)bl * SEQ;
    const int nks = (q0 + 31) / 128 + 1;
    __syncthreads();
    for (int i = tid; i < 32 * 1025 / 4; i += NTHREADS) ((LAS u32x4*)H11)[i] = (u32x4){0u, 0u, 0u, 0u};
    if (tid < 32) cc[tid] = 0u;
    if (tid == 0) *ovf = 0u;
    bf16x8 iq[2][8]; float iw[2][8];
#pragma unroll
    for (int qt = 0; qt < 2; ++qt) {
        const bf16_t* hr = H + (rowbase + q0 + qt * 16 + lr) * NP1;
#pragma unroll
        for (int h = 0; h < 8; ++h) iq[qt][h] = *(const bf16x8*)(hr + AIQ + h * 32 + lg * 8);
        const u32x4 w = *(const u32x4*)(hr + AIW); float f[8]; unpack8(w, f);
#pragma unroll
        for (int h = 0; h < 8; ++h) iw[qt][h] = f[h];
    }
    bf16x8 iql[2][2];
#pragma unroll
    for (int qt = 0; qt < 2; ++qt) {
        float qa[8];
#pragma unroll
        for (int i = 0; i < 8; ++i) qa[i] = 0.f;
#pragma unroll
        for (int h = 0; h < 8; ++h) { float qf8[8]; unpack8(__builtin_bit_cast(u32x4, iq[qt][h]), qf8);
#pragma unroll
            for (int i = 0; i < 8; ++i) qa[i] += iw[qt][h] * qf8[i]; }
        float qh[8], ql[8];
#pragma unroll
        for (int i = 0; i < 8; ++i) { qh[i] = bf2f(f2bf(qa[i])); ql[i] = qa[i] - qh[i]; }
        iql[qt][0] = __builtin_bit_cast(bf16x8, pack8(qh)); iql[qt][1] = __builtin_bit_cast(bf16x8, pack8(ql));
    }
    const int tq0 = q0 + lr, tq1 = q0 + 16 + lr;
    __syncthreads();
    const bf16_t* ikp = H + (rowbase + wid * 16 + lr) * NP1 + AIK + lg * 8;
    bf16x8 ikn0 = *(const bf16x8*)ikp, ikn1 = *(const bf16x8*)(ikp + (size_t)(nks > 1 ? 1 : 0) * 128 * NP1);
    for (int ks = 0; ks < nks; ++ks) {
        const int kb = ks * 128 + wid * 16;
        const bf16x8 ikf = ikn0; ikn0 = ikn1;
        { const int kn = (ks + 2 < nks) ? ks + 2 : nks - 1; ikn1 = *(const bf16x8*)(ikp + (size_t)kn * 128 * NP1); }
        float sc[2][4]; idx_scores(ikf, iq, iw, iql, sc);
        const bool chk = (ks == nks - 1);
#pragma unroll
        for (int qt = 0; qt < 2; ++qt) {
            const int tq = qt ? tq1 : tq0;
#pragma unroll
            for (int j = 0; j < 4; ++j) {
                const int key = kb + lg * 4 + j;
                const unsigned bin = mono_key(sc[qt][j]) >> 21;
                unsigned inc = (bin & 1u) ? 65536u : 1u;
                if (chk) inc = (key <= tq) ? inc : 0u;
                __hip_atomic_fetch_add(&H11[(qt * 16 + lr) * 1025 + (bin >> 1)], inc, __ATOMIC_RELAXED, __HIP_MEMORY_SCOPE_WORKGROUP);
            }
        }
    }
#ifdef DUP_IDX_P0
    { ikn0 = *(const bf16x8*)ikp; ikn1 = ikn0;
      for (int ks = 0; ks < nks; ++ks) {
        const bf16x8 ikf = ikn0; ikn0 = ikn1;
        { const int kn = (ks + 2 < nks) ? ks + 2 : nks - 1; ikn1 = *(const bf16x8*)(ikp + (size_t)kn * 128 * NP1); }
        float sc[2][4]; idx_scores(ikf, iq, iw, iql, sc);
#pragma unroll
        for (int qt = 0; qt < 2; ++qt)
#pragma unroll
            for (int j = 0; j < 4; ++j) { const unsigned bin = mono_key(sc[qt][j]) >> 21; unsigned inc = (bin == 5000u) ? 1u : 0u;
                __hip_atomic_fetch_add(&H11[(qt * 16 + lr) * 1025 + (bin >> 1)], inc, __ATOMIC_RELAXED, __HIP_MEMORY_SCOPE_WORKGROUP); }
      } }
#endif
#ifdef DUP_IDX_SC
    { float dsum = 0.f;
      ikn0 = *(const bf16x8*)ikp; ikn1 = ikn0;
      for (int ks = 0; ks < nks; ++ks) {
        const bf16x8 ikf = ikn0; ikn0 = ikn1;
        { const int kn = (ks + 2 < nks) ? ks + 2 : nks - 1; ikn1 = *(const bf16x8*)(ikp + (size_t)kn * 128 * NP1); }
        float sc[2][4]; idx_scores(ikf, iq, iw, iql, sc);
#pragma unroll
        for (int qt = 0; qt < 2; ++qt)
#pragma unroll
            for (int j = 0; j < 4; ++j) dsum += sc[qt][j];
      }
      if (dsum == 12345.678f) MASKB[0] = 1; }
#endif
    __syncthreads();
    for (int r = 0; r < 4; ++r) {
        const int row = wid * 4 + r;
        if (q0 + row < 256) { if (lane == 0) { tbin[row] = -1; need1[row] = 0u; } continue; }
        const LAS unsigned* hp = H11 + row * 1025 + 1008 - 16 * lane;
        unsigned c = 0u;
#pragma unroll
        for (int i = 0; i < 16; ++i) { const unsigned w = hp[i]; c += (w & 0xffffu) + (w >> 16); }
        int L1; unsigned ex1; wave_find(c, 256u, lane, L1, ex1);
        const int top = 2047 - 32 * L1; const unsigned need2 = 256u - ex1;
        unsigned c2 = 0u;
        if (lane < 32) { const int bin = top - lane; const unsigned w = H11[row * 1025 + (bin >> 1)]; c2 = (bin & 1) ? (w >> 16) : (w & 0xffffu); }
        int L2; unsigned ex2; wave_find(c2, need2, lane, L2, ex2);
        if (lane == 0) { tbin[row] = top - L2; need1[row] = need2 - ex2; }
    }
    __syncthreads();
    {
        const int tb0 = tbin[lr], tb1 = tbin[16 + lr];
        const float lo0 = tb0 < 0 ? -INFINITY : key_edge((unsigned)tb0 << 21), hi0 = tb0 < 0 ? -INFINITY : (tb0 >= 2047 ? INFINITY : key_edge(((unsigned)tb0 + 1u) << 21));
        const float lo1 = tb1 < 0 ? -INFINITY : key_edge((unsigned)tb1 << 21), hi1 = tb1 < 0 ? -INFINITY : (tb1 >= 2047 ? INFINITY : key_edge(((unsigned)tb1 + 1u) << 21));
        ikn0 = *(const bf16x8*)ikp; ikn1 = *(const bf16x8*)(ikp + (size_t)(nks > 1 ? 1 : 0) * 128 * NP1);
        for (int ks = 0; ks < nks; ++ks) {
            const int kb = ks * 128 + wid * 16;
            const bf16x8 ikf = ikn0; ikn0 = ikn1;
            { const int kn = (ks + 2 < nks) ? ks + 2 : nks - 1; ikn1 = *(const bf16x8*)(ikp + (size_t)kn * 128 * NP1); }
            float sc[2][4]; idx_scores(ikf, iq, iw, iql, sc);
            const bool chk = (ks == nks - 1);
#pragma unroll
            for (int qt = 0; qt < 2; ++qt) {
                const int tq = qt ? tq1 : tq0; const float loe = qt ? lo1 : lo0, hie = qt ? hi1 : hi0; const int q = qt * 16 + lr;
                unsigned b = 0u;
#pragma unroll
                for (int j = 0; j < 4; ++j) {
                    const int key = kb + lg * 4 + j;
                    const float sv = sc[qt][j];
                    const bool causal = !chk || (key <= tq);
                    const bool above = sv >= hie;
                    b |= (causal && above) ? (1u << (lg * 4 + j)) : 0u;
                    if (causal && !above && sv >= loe) {
                        const unsigned slot = __hip_atomic_fetch_add(&cc[q], 1u, __ATOMIC_RELAXED, __HIP_MEMORY_SCOPE_WORKGROUP);
                        if (slot < (unsigned)ICAP) { KL[q * ICAP + slot] = mono_key(sv); IL[q * ICAP + slot] = (unsigned short)key; }
                    }
                }
                b |= __shfl_xor(b, 16); b |= __shfl_xor(b, 32);
                if (lg == 0) *(LAS unsigned short*)(LM + q * 1024 + (ks * 8 + wid) * 2) = (unsigned short)b;
            }
        }
    }
    __syncthreads();
    if (tid < 32 && cc[tid] > (unsigned)ICAP) *ovf = 1u;
    __syncthreads();
    if (*ovf != 0u) return false;
    for (int r = 0; r < 4; ++r) {
        const int row = wid * 4 + r; const int n = (int)cc[row]; const int tb = tbin[row];
        if (tb < 0 || n == 0) continue;
        unsigned need = need1[row], pfx = 0u, cnt_eq = 0u;
        LAS unsigned* hh = hist2 + wid * 128;
#pragma unroll 1
        for (int rp = 0; rp < 3; ++rp) {
            const int shift = 14 - 7 * rp;
            hh[lane] = 0u; hh[64 + lane] = 0u;
            __builtin_amdgcn_wave_barrier();
            for (int e = lane; e < n; e += 64) {
                const unsigned k = KL[row * ICAP + e] & 0x1fffffu;
                if (rp == 0 || (k >> (shift + 7)) == pfx) __hip_atomic_fetch_add(&hh[(k >> shift) & 127u], 1u, __ATOMIC_RELAXED, __HIP_MEMORY_SCOPE_WORKGROUP);
            }
            __builtin_amdgcn_wave_barrier();
            const unsigned c_hi = hh[127 - 2 * lane], c_lo = hh[126 - 2 * lane];
            __builtin_amdgcn_wave_barrier();
            int L; unsigned ex; wave_find(c_hi + c_lo, need, lane, L, ex);
            const unsigned chiL = __shfl(c_hi, L), cloL = __shfl(c_lo, L);
            unsigned rem = need - ex; unsigned digit;
            if (rem <= chiL) { digit = 127u - 2u * (unsigned)L; cnt_eq = chiL; } else { digit = 126u - 2u * (unsigned)L; rem -= chiL; cnt_eq = cloL; }
            pfx = (pfx << 7) | digit; need = rem;
        }
        for (int e = lane; e < n; e += 64) {
            const unsigned k = KL[row * ICAP + e] & 0x1fffffu; const unsigned idx = IL[row * ICAP + e];
            bool sel = k > pfx;
            if (k == pfx) {
                if (cnt_eq <= need) sel = true;
                else { unsigned rank = 0u; for (int e2 = 0; e2 < n; ++e2) { const unsigned k2 = KL[row * ICAP + e2] & 0x1fffffu; const unsigned i2 = IL[row * ICAP + e2]; rank += (k2 == pfx && i2 < idx) ? 1u : 0u; } sel = rank < need; }
            }
            if (sel) __hip_atomic_fetch_or((LAS unsigned*)(LM + row * 1024) + (idx >> 5), 1u << (idx & 31u), __ATOMIC_RELAXED, __HIP_MEMORY_SCOPE_WORKGROUP);
        }
    }
    __syncthreads();
    for (int c = tid; c < 32 * nks; c += NTHREADS) { const int row = c / nks, ch = c % nks; *(u32x4*)(MASKB + (rowbase + q0 + row) * 1024 + ch * 16) = *(const LAS u32x4*)(LM + row * 1024 + ch * 16); }
    __syncthreads();
    return true;
}

struct AttnArgs {
    const bf16_t* q; long q_rs; const bf16_t* k; long k_rs; const bf16_t* v; long v_rs;
    int i0; int maxdist; float bound; float l_init;
    const unsigned long long* mask;
    bf16_t* o; long o_rs; const bf16_t* z; long z_rs; float* md; long md_rs;
};
template <int DQK, int VAR>
__device__ __forceinline__ void attn_tile(const LAS bf16_t* sK, const LAS bf16_t* sVt, const LAS float* sBias, const bf16x8 (&qf)[2][DQK / 32], f32x4 (&o)[2][4], float (&lsum)[2],
                                          int qi, int key0, int maxdist, const unsigned (&mlo)[2], const unsigned (&mhi)[2], float sinit, int lr, int lg) {
    constexpr int KP = DQK + 8, VP = 72;
    f32x4 s[2][4];
    u32x4 vfr[2][4];
#pragma unroll
    for (int ch = 0; ch < 2; ++ch) {
        bf16x8 kfr[2][DQK / 32];
#pragma unroll
        for (int c = 0; c < 2; ++c)
#pragma unroll
            for (int ks = 0; ks < DQK / 32; ++ks) kfr[c][ks] = *(const LAS bf16x8*)(sK + ((ch * 2 + c) * 16 + lr) * KP + ks * 32 + lg * 8);
        __builtin_amdgcn_sched_barrier(0);
        __builtin_amdgcn_s_setprio(1);
#pragma unroll
        for (int c = 0; c < 2; ++c) {
            s[0][ch * 2 + c] = (f32x4){sinit, sinit, sinit, sinit}; s[1][ch * 2 + c] = s[0][ch * 2 + c];
#pragma unroll
            for (int ks = 0; ks < DQK / 32; ++ks) {
                s[0][ch * 2 + c] = __builtin_amdgcn_mfma_f32_16x16x32_bf16(kfr[c][ks], qf[0][ks], s[0][ch * 2 + c], 0, 0, 0);
                s[1][ch * 2 + c] = __builtin_amdgcn_mfma_f32_16x16x32_bf16(kfr[c][ks], qf[1][ks], s[1][ch * 2 + c], 0, 0, 0);
            }
        }
        __builtin_amdgcn_s_setprio(0);
        __builtin_amdgcn_sched_barrier(0);
    }
    __builtin_amdgcn_s_setprio(0);
    __builtin_amdgcn_sched_barrier(0);
#pragma unroll
    for (int kk = 0; kk < 2; ++kk)
#pragma unroll
        for (int dt = 0; dt < 4; ++dt) {
            const LAS bf16_t* vp = sVt + (dt * 16 + lr) * VP + kk * 32 + lg * 4;
            const u32x2 v0 = *(const LAS u32x2*)vp, v1 = *(const LAS u32x2*)(vp + 16);
            vfr[kk][dt].x = v0.x; vfr[kk][dt].y = v0.y; vfr[kk][dt].z = v1.x; vfr[kk][dt].w = v1.y;
        }
    __builtin_amdgcn_sched_barrier(0);
#pragma unroll
    for (int qt = 0; qt < 2; ++qt) {
        const int dq = qi + qt * 16 - key0 - lg * 4;
        const LAS float* bp = sBias + (dq + 33);
        float ps = 0.f;
#pragma unroll
        for (int c = 0; c < 4; ++c)
#pragma unroll
            for (int j = 0; j < 4; ++j) {
                float val = s[qt][c][j]; float pv;
                if (VAR == 0) pv = fexp2(val);
                else if (VAR == 1) { pv = fexp2(val); pv = (dq >= c * 16 + j) ? pv : 0.f; }
                else if (VAR == 2) { pv = fexp2(val + bp[63 - (c * 16 + j)]); }
                else if (VAR == 3) { pv = fexp2(val); pv = __uint_as_float(__float_as_uint(pv) & (unsigned)__builtin_amdgcn_sbfe((int)(c < 2 ? mlo[qt] : mhi[qt]), (c & 1) * 16 + j, 1)); }
                else { pv = fexp2(val + bp[63 - (c * 16 + j)]); pv = __uint_as_float(__float_as_uint(pv) & (unsigned)__builtin_amdgcn_sbfe((int)(c < 2 ? mlo[qt] : mhi[qt]), (c & 1) * 16 + j, 1)); }
                s[qt][c][j] = pv; ps += pv;
            }
        lsum[qt] += ps;
    }
    __builtin_amdgcn_s_setprio(1);
#pragma unroll
    for (int kk = 0; kk < 2; ++kk) {
        bf16x8 pb[2];
#pragma unroll
        for (int qt = 0; qt < 2; ++qt) {
            u32x4 pw; pw.x = pk2(s[qt][2 * kk][0], s[qt][2 * kk][1]); pw.y = pk2(s[qt][2 * kk][2], s[qt][2 * kk][3]); pw.z = pk2(s[qt][2 * kk + 1][0], s[qt][2 * kk + 1][1]); pw.w = pk2(s[qt][2 * kk + 1][2], s[qt][2 * kk + 1][3]);
            pb[qt] = __builtin_bit_cast(bf16x8, pw);
        }
#pragma unroll
        for (int dt = 0; dt < 4; ++dt) {
            const bf16x8 vf = __builtin_bit_cast(bf16x8, vfr[kk][dt]);
            o[0][dt] = __builtin_amdgcn_mfma_f32_16x16x32_bf16(vf, pb[0], o[0][dt], 0, 0, 0);
            o[1][dt] = __builtin_amdgcn_mfma_f32_16x16x32_bf16(vf, pb[1], o[1][dt], 0, 0, 0);
        }
    }
    __builtin_amdgcn_s_setprio(0);
}
template <int DQK, int MODE>
__device__ __forceinline__ void attn_unit(LAS unsigned char* lds, const AttnArgs& a, const unsigned char* lut) {
    constexpr int KP = DQK + 8, VP = 72, KCH = DQK / 8;
    const LAS float* sBias = (const LAS float*)(lds + 49152);
    LAS unsigned char* sUni = (LAS unsigned char*)(lds + 83968);
    const int tid = otid(), wid = __builtin_amdgcn_readfirstlane(tid >> 6), lane = tid & 63, lr = lane & 15, lg = lane >> 4;
    const int i0 = a.i0; const int qi = i0 + wid * 32 + lr;
    const int kt_hi = (i0 + 255) >> 6;
    int kt_lo = 0;
    if (MODE == 1) { const int lo = i0 - a.maxdist; kt_lo = lo > 0 ? (lo >> 6) : 0; }
    const int wq_min = i0 + wid * 32, wq_max = wq_min + 31;
    if (MODE == 2) {
        for (int e = tid; e < 8 * (kt_hi + 1); e += NTHREADS) {
            const int w = e / (kt_hi + 1), kt = e % (kt_hi + 1);
            const int dmin = i0 + w * 32 - (kt * 64 + 63), dmax = i0 + w * 32 + 31 - kt * 64;
            sUni[w * 132 + kt] = (dmin >= 0 && lut[dmin] == lut[dmax]) ? 1 : 0;
        }
    }
    bf16x8 qf[2][DQK / 32];
#pragma unroll
    for (int qt = 0; qt < 2; ++qt)
#pragma unroll
        for (int ks = 0; ks < DQK / 32; ++ks) qf[qt][ks] = *(const bf16x8*)(a.q + (long)(qi + qt * 16) * a.q_rs + ks * 32 + lg * 8);
    float lsum[2]; lsum[0] = (lg == 0) ? a.l_init : 0.f; lsum[1] = lsum[0];
    const float nb = -a.bound;
    f32x4 o[2][4];
#pragma unroll
    for (int qt = 0; qt < 2; ++qt)
#pragma unroll
        for (int d = 0; d < 4; ++d) o[qt][d] = (f32x4){0.f, 0.f, 0.f, 0.f};
    u32x4 rk0, rk1; u32x2 rv0, rv1;
    const int kkey0 = tid / KCH, kpart0 = tid % KCH; const int kkey1 = (tid + 512) / KCH, kpart1 = (tid + 512) % KCH;
    const int vkp = tid & 31, vdg = tid >> 5;
#define ATT_LOAD(kt) do { const long kb_ = (long)(kt) * 64; \
        rk0 = *(const u32x4*)(a.k + (kb_ + kkey0) * a.k_rs + kpart0 * 8); \
        if (DQK == 96 && tid < 256) rk1 = *(const u32x4*)(a.k + (kb_ + kkey1) * a.k_rs + kpart1 * 8); \
        rv0 = *(const u32x2*)(a.v + (kb_ + 2 * vkp) * a.v_rs + vdg * 4); rv1 = *(const u32x2*)(a.v + (kb_ + 2 * vkp + 1) * a.v_rs + vdg * 4); } while (0)
#define ATT_STORE(buf) do { LAS bf16_t* sK_ = (LAS bf16_t*)(lds + (buf) * 24576); LAS bf16_t* sV_ = (LAS bf16_t*)(lds + (buf) * 24576 + 14336); \
        *(LAS u32x4*)(sK_ + kkey0 * KP + kpart0 * 8) = rk0; \
        if (DQK == 96 && tid < 256) *(LAS u32x4*)(sK_ + kkey1 * KP + kpart1 * 8) = rk1; \
        *(LAS unsigned*)(sV_ + (vdg * 4 + 0) * VP + 2 * vkp) = (rv0.x & 0xffffu) | (rv1.x << 16); \
        *(LAS unsigned*)(sV_ + (vdg * 4 + 1) * VP + 2 * vkp) = (rv0.x >> 16) | (rv1.x & 0xffff0000u); \
        *(LAS unsigned*)(sV_ + (vdg * 4 + 2) * VP + 2 * vkp) = (rv0.y & 0xffffu) | (rv1.y << 16); \
        *(LAS unsigned*)(sV_ + (vdg * 4 + 3) * VP + 2 * vkp) = (rv0.y >> 16) | (rv1.y & 0xffff0000u); } while (0)
    ATT_LOAD(kt_lo);
    ATT_STORE(0);
    if (kt_lo < kt_hi) ATT_LOAD(kt_lo + 1);
    unsigned long long mwn0 = 0ull, mwn1 = 0ull;
    if (MODE == 2) { mwn0 = a.mask[(long)qi * 128 + kt_lo]; mwn1 = a.mask[(long)(qi + 16) * 128 + kt_lo]; }
    __syncthreads();
    for (int kt = kt_lo; kt <= kt_hi; ++kt) {
        const int cur = (kt - kt_lo) & 1;
        if (kt < kt_hi) ATT_STORE(cur ^ 1);
        if (kt + 1 < kt_hi) ATT_LOAD(kt + 2);
        const unsigned long long mwc0 = mwn0, mwc1 = mwn1;
        if (MODE == 2 && kt < kt_hi) { mwn0 = a.mask[(long)qi * 128 + kt + 1]; mwn1 = a.mask[(long)(qi + 16) * 128 + kt + 1]; }
        const LAS bf16_t* sK = (const LAS bf16_t*)(lds + cur * 24576); const LAS bf16_t* sVt = (const LAS bf16_t*)(lds + cur * 24576 + 14336);
        const int key0 = kt * 64;
        bool skip = key0 > wq_max;
        if (MODE == 1) skip = skip || (key0 + 63 < wq_min - a.maxdist);
        if (!skip) {
            unsigned mlo[2] = {0u, 0u}, mhi[2] = {0u, 0u};
            if (MODE == 0) {
                if (key0 + 63 <= wq_min) attn_tile<DQK, 0>(sK, sVt, sBias, qf, o, lsum, qi, key0, 0, mlo, mhi, nb, lr, lg);
                else attn_tile<DQK, 1>(sK, sVt, sBias, qf, o, lsum, qi, key0, 0, mlo, mhi, nb, lr, lg);
            } else if (MODE == 1) {
                attn_tile<DQK, 2>(sK, sVt, sBias, qf, o, lsum, qi, key0, a.maxdist, mlo, mhi, nb, lr, lg);
            } else {
                const unsigned long long w0 = mwc0 >> (lg * 4), w1 = mwc1 >> (lg * 4);
                mlo[0] = (unsigned)w0; mhi[0] = (unsigned)(w0 >> 32); mlo[1] = (unsigned)w1; mhi[1] = (unsigned)(w1 >> 32);
                const int uni = __builtin_amdgcn_readfirstlane((int)sUni[wid * 132 + kt]);
                if (uni) { const float ub = sBias[96 + wq_min - key0]; attn_tile<DQK, 3>(sK, sVt, sBias, qf, o, lsum, qi, key0, 0, mlo, mhi, nb + ub, lr, lg); }
                else attn_tile<DQK, 4>(sK, sVt, sBias, qf, o, lsum, qi, key0, 0, mlo, mhi, nb, lr, lg);
            }
        }
        __syncthreads();
    }
#undef ATT_LOAD
#undef ATT_STORE
#pragma unroll
    for (int qt = 0; qt < 2; ++qt) {
        const int qr = qi + qt * 16;
        float lt = lsum[qt]; lt += __shfl_xor(lt, 16); lt += __shfl_xor(lt, 32);
        const float inv = 1.0f / lt;
        u32x2 zw[4];
#pragma unroll
        for (int dt = 0; dt < 4; ++dt) zw[dt] = (u32x2){0x3f803f80u, 0x3f803f80u};
        if (a.z) {
#pragma unroll
            for (int dt = 0; dt < 4; ++dt) zw[dt] = *(const u32x2*)(a.z + (long)qr * a.z_rs + dt * 16 + lg * 4);
        }
#pragma unroll
        for (int dt = 0; dt < 4; ++dt) {
            float r[4];
#pragma unroll
            for (int j = 0; j < 4; ++j) r[j] = o[qt][dt][j] * inv;
            const int col = dt * 16 + lg * 4;
            if (a.z) {
                r[0] *= silu_f(__uint_as_float(zw[dt].x << 16)); r[1] *= silu_f(__uint_as_float(zw[dt].x & 0xffff0000u));
                r[2] *= silu_f(__uint_as_float(zw[dt].y << 16)); r[3] *= silu_f(__uint_as_float(zw[dt].y & 0xffff0000u)); }
            u32x2 w; w.x = pk2(r[0], r[1]); w.y = pk2(r[2], r[3]);
            *(u32x2*)(a.o + (long)qr * a.o_rs + col) = w;
        }
        if (a.md && lg == 0) { a.md[(long)qr * a.md_rs] = a.bound; a.md[(long)qr * a.md_rs + 1] = lt; }
    }
}

__device__ __forceinline__ float logit_bound(const float* gq, const float* gk, int dim, const float* bias_col, float extra) {
    const int lane = otid() & 63;
    float a = 0.f, b = 0.f, c = 0.f;
    for (int i = lane; i < dim; i += 64) { a = fmaxf(a, fabsf(gq[i])); b = fmaxf(b, fabsf(gk[i])); }
    if (bias_col && lane < 32) c = fabsf(bias_col[lane * NBH]);
#pragma unroll
    for (int o = 1; o < 64; o <<= 1) { a = fmaxf(a, __shfl_xor(a, o)); b = fmaxf(b, __shfl_xor(b, o)); c = fmaxf(c, __shfl_xor(c, o)); }
    return sqrtf((float)dim) * a * b * LOG2E * 1.03f + c * LOG2E + 0.25f + extra;
}

__device__ __forceinline__ void bcombine_phase(const bf16_t* H, const float* MD, bf16_t* YZ, int Tc) {
    const int lane = otid() & 63; const int gw = (obid() * NTHREADS + otid()) >> 6, nw = (gridDim.x * NTHREADS) >> 6;
    const int h = lane >> 3, d0 = (lane & 7) * 8;
    for (int row = gw; row < Tc; row += nw) {
        float mm[3], dd[3];
#pragma unroll
        for (int g = 0; g < 3; ++g) { mm[g] = MD[((size_t)row * 24 + g * 8 + h) * 2]; dd[g] = MD[((size_t)row * 24 + g * 8 + h) * 2 + 1]; }
        const float M = fmaxf(mm[0], fmaxf(mm[1], mm[2]));
        float w[3]; float ws = 0.f;
#pragma unroll
        for (int g = 0; g < 3; ++g) { w[g] = dd[g] * fexp2(mm[g] - M); ws += w[g]; }
        const float inv = 1.0f / ws;
        float acc[8];
#pragma unroll
        for (int i = 0; i < 8; ++i) acc[i] = 0.f;
#pragma unroll
        for (int g = 0; g < 3; ++g) { const u32x4 ow = *(const u32x4*)(H + (size_t)row * NP1 + BQ + g * 512 + h * 64 + d0); float f[8]; unpack8(ow, f);
#pragma unroll
            for (int i = 0; i < 8; ++i) acc[i] += w[g] * inv * f[i]; }
        const u32x4 zw = *(const u32x4*)(H + (size_t)row * NP1 + BZ + h * 64 + d0); float zf[8]; unpack8(zw, zf);
#pragma unroll
        for (int i = 0; i < 8; ++i) acc[i] *= silu_f(zf[i]);
        *(u32x4*)(YZ + (size_t)row * 2048 + 512 + h * 64 + d0) = pack8(acc);
    }
}

__global__ void __launch_bounds__(NTHREADS) mega_fwd(Params p) {
    extern __shared__ __attribute__((aligned(16))) unsigned char lds_raw[];
    LAS unsigned char* lds = (LAS unsigned char*)lds_raw;
    cg::grid_group grid = cg::this_grid();
    const int nbc = p.nbc, Tc = nbc * SEQ, nchunk = NBATCH / nbc;
    const int G = gridDim.x, bx = obid(), tid = otid();

    { LAS unsigned* misc = (LAS unsigned*)(lds + LDS_MISC); if (tid < 16) misc[tid] = 0u; }
    __syncthreads();
    XcdBarrier xb = xcd_barrier_post((unsigned*)(p.ws + 4096), (volatile LAS unsigned*)(lds + LDS_MISC + 32));
    { const WsMap wm = make_map(nbc); setup_phase(p, wm, lds); }
    grid.sync();

#pragma unroll 1
    for (int l = 0; l < DEPTH; ++l) {
        const float* xin = (l == 0) ? p.x : p.out;
        { const WsMap wm = make_map(nbc); p0_phase(xin, p.norm_gain + l * DM, (bf16_t*)(p.ws + wm.xb)); }
        xcd_barrier(xb);
#pragma unroll 1
        for (int ch = 0; ch < nchunk; ++ch) {
#pragma unroll 1
            for (int ph = 0; ph < 13; ++ph) {
                const WsMap wm = make_map(nbc);
                bf16_t* XB = (bf16_t*)(p.ws + wm.xb); bf16_t* H = (bf16_t*)(p.ws + wm.h);
                bf16_t* QC = (bf16_t*)(p.ws + wm.qc); bf16_t* KC = (bf16_t*)(p.ws + wm.kc); bf16_t* KV = (bf16_t*)(p.ws + wm.kv);
                unsigned long long* MASK = (unsigned long long*)(p.ws + wm.mask); float* MD = (float*)(p.ws + wm.md);
                bf16_t* YZ = (bf16_t*)(p.ws + wm.yz); float* MG = (float*)(p.ws + wm.mg); bf16_t* MGb = (bf16_t*)(p.ws + wm.mgb);
                const unsigned char* lut = p.ws + wm.lut;
                const float* biasd = (const float*)(p.ws + wm.biasd); const float* bnd = (const float*)(p.ws + wm.bnd);
                int* ctl = (int*)(p.ws + wm.ctl);
                const size_t tok0 = (size_t)ch * Tc;
                bool do_sync = true;
                if (ph == 0) {
                    pg8::Gemm g{XB + tok0 * DM, (const bf16_t*)(p.ws + wm.winT) + (size_t)l * NP1 * DM, Tc, NP1, DM, DM, 0, 0};
                    pg8::EpiStoreNorm E{H, p.qga + l * 128, p.qgb + l * 128, p.qgd + l * 128, (LAS float*)(lds + LDS_MISC + 6144)};
                    pg8::StaticOrder S; S.init(g.M, g.N, G, bx);
#ifndef SK_GS
                    pg8::gemm_phase(lds, g, S, E);
#endif
                } else if (ph == 2 || ph == 3 || ph == 7) {
                    pg8::Gemm g; pg8::EpiStore E;
                    if (ph == 2) { g = pg8::Gemm{H + CQ, (const bf16_t*)(p.ws + wm.wqbT) + (size_t)l * 768 * 256, Tc, 768, 256, NP1, 0, 0}; E = pg8::EpiStore{QC, 768, 0}; do_sync = false; }
                    else if (ph == 3) { g = pg8::Gemm{H + CKV, (const bf16_t*)(p.ws + wm.wkvbT) + (size_t)l * 1024 * 128, Tc, 1024, 128, NP1, 0, 0}; E = pg8::EpiStore{KV, 1024, 0}; }
                    else { g = pg8::Gemm{XB + tok0 * DM, (const bf16_t*)(p.ws + wm.wgT) + (size_t)l * 4096 * DM, Tc, 4096, DM, DM, 0, 0}; E = pg8::EpiStore{H + BQ, NP1, 1}; }
                    pg8::StaticOrder S; S.init(g.M, g.N, G, bx);
#ifndef SK_GS
                    pg8::gemm_phase(lds, g, S, E);
#endif
#ifdef DUP_GS
                    if (ph == 0) pg8::gemm_phase(lds, g, S, E);
#endif
#ifdef DUP_GG
                    if (ph == 7) pg8::gemm_phase(lds, g, S, E);
#endif
#ifdef DUP_GM
                    if (ph == 2 || ph == 3) pg8::gemm_phase(lds, g, S, E);
#endif
                } else if (ph == 1) {
                    norm_phase(p, H, Tc, l);
                } else if (ph == 4) {
                    mla_phase(p, wm, H, QC, KC, KV, Tc, l);
                } else if (ph == 5) {
                    int* ctr = ctl + (l * 4 + ch) * 2;
                    const int n_idx = nbc * 256, n_c = nbc * 8 * 32, n_b = 3 * nbc * 8 * 32, n_d = nbc * 8 * 32;
                    const int n_all = n_idx + n_c + n_b + n_d;
                    for (;;) {
                        int u = next_unit(ctr, lds);
                        if (u >= n_all) break;
                        if (u < n_idx) { const int qb = 255 - u / nbc, bl = u % nbc;
#ifndef SK_IDX
 if (!indexer_fast(lds, H, (unsigned char*)MASK, bl, qb)) indexer_unit(lds, H, (unsigned short*)MASK, bl, qb);
#endif
#ifdef DUP_IDX
 if (!indexer_fast(lds, H, (unsigned char*)MASK, bl, qb)) indexer_unit(lds, H, (unsigned short*)MASK, bl, qb);
#endif
 }
                        else if (u < n_idx + n_c) {
                            u -= n_idx;
                            const int blk = 31 - u / (nbc * 8), rem = u % (nbc * 8), bl = rem / 8, h = rem % 8;
                            AttnArgs a; const size_t r0 = (size_t)bl * SEQ;
                            a.q = QC + r0 * 768 + h * 96; a.q_rs = 768; a.k = KC + r0 * 768 + h * 96; a.k_rs = 768; a.v = KV + r0 * 1024 + h * 128 + 64; a.v_rs = 1024;
                            a.i0 = blk * 256; a.maxdist = 0; a.bound = bnd[l * 4 + 2]; a.l_init = 0.f; a.mask = nullptr;
                            a.o = YZ + r0 * 2048 + 1024 + h * 64; a.o_rs = 2048; a.z = H + r0 * NP1 + CZ + h * 64; a.z_rs = NP1; a.md = nullptr; a.md_rs = 0;
#ifndef SK_C
                            attn_unit<96, 0>(lds, a, lut);
#endif
#ifdef DUP_C
                            attn_unit<96, 0>(lds, a, lut);
#endif
                        } else {
                            u -= n_idx + n_c;
                            AttnArgs a; int dil, bcol;
                            if (u < n_b) {
                                const int g = u / (nbc * 8 * 32); int rem = u % (nbc * 8 * 32);
                                const int bl = rem / (8 * 32); rem %= (8 * 32); const int h = rem / 32; const int rb = rem % 32;
                                dil = (g == 0) ? 1 : (g == 1 ? 4 : 16); const int nblk = 32 / dil; const int r = rb / nblk, blk = rb % nblk;
                                bcol = 8 + g * 8 + h;
                                const size_t r0 = (size_t)bl * SEQ + r;
                                a.q = H + r0 * NP1 + BQ + g * 512 + h * 64; a.q_rs = (long)dil * NP1; a.k = H + r0 * NP1 + BKK + g * 512 + h * 64; a.k_rs = (long)dil * NP1;
                                a.v = H + r0 * NP1 + BV + g * 512 + h * 64; a.v_rs = (long)dil * NP1;
                                a.i0 = blk * 256; a.maxdist = 128; a.bound = bnd[l * 4 + 1]; a.l_init = 0.f; a.mask = nullptr;
                                a.o = H + r0 * NP1 + BQ + g * 512 + h * 64; a.o_rs = (long)dil * NP1; a.z = nullptr; a.z_rs = 0;
                                a.md = MD + (r0 * 24 + g * 8 + h) * 2; a.md_rs = (long)dil * 48;
                            } else {
                                u -= n_b;
                                const int bl = u / (8 * 32); const int rem = u % (8 * 32); const int h = rem / 32, blk = rem % 32;
                                dil = 1; bcol = 32 + h;
                                const size_t r0 = (size_t)bl * SEQ;
                                a.q = H + r0 * NP1 + DQ + h * 64; a.q_rs = NP1; a.k = H + r0 * NP1 + DK + (h >> 2) * 64; a.k_rs = NP1; a.v = H + r0 * NP1 + DV + (h >> 2) * 64; a.v_rs = NP1;
                                a.i0 = blk * 256; a.maxdist = 127; { const float sk = p.sinks[l * 8 + h] * LOG2E; a.bound = bnd[l * 4 + 3] + fmaxf(sk, 0.f); a.l_init = fexp2(sk - a.bound); } a.mask = nullptr;
                                a.o = YZ + r0 * 2048 + 1536 + h * 64; a.o_rs = 2048; a.z = H + r0 * NP1 + DZ + h * 64; a.z_rs = NP1; a.md = nullptr; a.md_rs = 0;
                            }
                            LAS float* sBias = (LAS float*)(lds + 49152); const int t2 = otid();
                            if (t2 < 96 + 129 + 96) { const int d = t2 - 96; sBias[t2] = (d < 0 || d > a.maxdist) ? -INFINITY : biasd[bcol * SEQ + d * dil]; }
#ifndef SK_B
                            attn_unit<64, 1>(lds, a, lut);
#endif
#ifdef DUP_D
                            if (a.md == nullptr) attn_unit<64, 1>(lds, a, lut);
#endif
                        }
                    }
                } else if (ph == 6) {
                    int* ctr = ctl + (l * 4 + ch) * 2 + 1;
                    const int n_a = nbc * 8 * 32;
                    for (;;) {
                        int u = next_unit(ctr, lds);
                        if (u >= n_a) break;
                        const int blk = 31 - u / (nbc * 8), rem = u % (nbc * 8), bl = rem / 8, h = rem % 8;
                        LAS float* sBias = (LAS float*)(lds + 49152); const int t2 = otid();
                        if (t2 < 96) sBias[t2] = 0.f;
                        for (int d = t2 * 4; d < blk * 256 + 256; d += NTHREADS * 4) *(LAS f32x4*)(sBias + 96 + d) = *(const f32x4*)(biasd + h * SEQ + d);
                        AttnArgs a; const size_t r0 = (size_t)bl * SEQ;
                        a.q = H + r0 * NP1 + AQ + h * 64; a.q_rs = NP1; a.k = H + r0 * NP1 + AK + h * 64; a.k_rs = NP1; a.v = H + r0 * NP1 + AV + h * 64; a.v_rs = NP1;
                        a.i0 = blk * 256; a.maxdist = 0; a.bound = bnd[l * 4 + 0]; a.l_init = 0.f; a.mask = MASK + r0 * 128;
                        a.o = YZ + r0 * 2048 + h * 64; a.o_rs = 2048; a.z = H + r0 * NP1 + AZ + h * 64; a.z_rs = NP1; a.md = nullptr; a.md_rs = 0;
#ifndef SK_A
                        attn_unit<64, 2>(lds, a, lut);
#endif
#ifdef DUP_A
                        attn_unit<64, 2>(lds, a, lut);
#endif
                    }
                    bcombine_phase(H, MD, YZ, Tc);
                } else if (ph < 12) {
                    if (ph == 8) {
                        pg8::Gemm g{YZ, (const bf16_t*)(p.ws + wm.wbrT) + (size_t)l * 4 * 1024 * 512, Tc, 1024, 512, 2048, (size_t)512 * 2, (size_t)1024 * 512 * 2};
                        pg8::BatchOrder4 S; S.base.init(Tc, 1024, G, bx);
                        pg8::EpiBranch E{MGb, H + BQ, NP1};
#ifndef SK_GB
                        pg8::gemm_phase(lds, g, S, E);
#endif
                    } else do_sync = false;
                } else {
                    pg8::Gemm g{MGb, (const bf16_t*)(p.ws + wm.woT) + (size_t)l * 1024 * 1024, Tc, 1024, 1024, 1024, 0, 0}; pg8::StaticOrder S; S.init(Tc, 1024, G, bx);
                    pg8::EpiOut E{xin + tok0 * DM, p.out + tok0 * DM};
#ifndef SK_GO
 pg8::gemm_phase(lds, g, S, E);
#endif
                }
                if (do_sync) xcd_barrier(xb);
#ifdef DUP_SYNC
                if (do_sync) xcd_barrier(xb);
#endif
            }
        }
    }
}

extern "C" void kernel_launch(void* const* d_in, const int* in_sizes, int n_in, void* d_out, int out_size, void* d_ws, size_t ws_size, hipStream_t stream) {
    static int grid_blocks = 0;
    if (!grid_blocks) {
        int dev = 0, cus = 0, per_cu = 0;
        hipGetDevice(&dev);
        hipDeviceGetAttribute(&cus, hipDeviceAttributeMultiprocessorCount, dev);
        hipFuncSetAttribute((const void*)mega_fwd, hipFuncAttributeMaxDynamicSharedMemorySize, LDS_BYTES);
        hipOccupancyMaxActiveBlocksPerMultiprocessor(&per_cu, (const void*)mega_fwd, NTHREADS, LDS_BYTES);
        if (per_cu < 1) per_cu = 1;
        if (per_cu > 1) per_cu = 1;
        grid_blocks = cus * per_cu;
    }
    Params p{};
    p.x = (const float*)d_in[0]; p.norm_gain = (const float*)d_in[1]; p.w_in = (const float*)d_in[2]; p.qga = (const float*)d_in[3]; p.qgb = (const float*)d_in[4];
    p.qgc = (const float*)d_in[5]; p.qgd = (const float*)d_in[6]; p.cq_gain = (const float*)d_in[7]; p.ckv_gain = (const float*)d_in[8]; p.w_q_b = (const float*)d_in[9];
    p.w_kv_b = (const float*)d_in[10]; p.sinks = (const float*)d_in[11]; p.rel_bias = (const float*)d_in[12]; p.w_branch = (const float*)d_in[13]; p.w_out = (const float*)d_in[14];
    p.out = (float*)d_out; p.ws = (unsigned char*)d_ws;
    p.nbc = (make_map(2).total <= ws_size) ? 2 : 1; p.pad = 0;
    hipMemsetAsync(d_ws, 0, 32768, stream);
    void* args[] = {&p};
    hipError_t e = hipLaunchCooperativeKernel((const void*)mega_fwd, dim3(grid_blocks), dim3(NTHREADS), args, LDS_BYTES, stream);
    if (e != hipSuccess) fprintf(stderr, "cooperative launch failed: %s (grid %d)\n", hipGetErrorString(e), grid_blocks);
}
```
